# Optimizing an MI355X kernel written in HIP

```python
import jax
import jax.numpy as jnp
from jax import lax
import numpy as np

D_MODEL = 1024
BATCH = 8
SEQ = 2048
DEPTH = 2

CHUNK = 64
MEM_LEN = 256
RET_HEADS = 4
RET_HD = 128
RET_W = RET_HEADS * RET_HD
ROPE_BASE = 10000.0
RWKV_HEADS = 8
RWKV_HD = 64
RWKV_W = RWKV_HEADS * RWKV_HD
W_LORA = 64
A_LORA = 64
G_LORA = 128
RWKV_GN_EPS = 64e-5
XA_HEADS = 4
XA_HD = D_MODEL // XA_HEADS
N_EXPERTS = 16
N_GROUPS = 4
EXPERTS_PER_GROUP = N_EXPERTS // N_GROUPS
TOP_K = 2
D_EXPERT = 512
ALPHA = (2 * DEPTH) ** 0.25
BETA = (8 * DEPTH) ** -0.25
LN_EPS = 1e-5
RET_COLS = 4 * RET_W
RWKV_COLS = 3 * RWKV_W + W_LORA + A_LORA + G_LORA
GATE_COLS = 2 * D_MODEL
N_IN = RET_COLS + RWKV_COLS + GATE_COLS

kernel_name = 'hybrid_retention_rwkv7_memxattn_groupmoe_deepnorm'


def layer_norm(x, g, b, eps=LN_EPS):
    xf = x.astype(jnp.float32)
    mu = jnp.mean(xf, axis=-1, keepdims=True)
    var = jnp.mean(jnp.square(xf - mu), axis=-1, keepdims=True)
    y = (xf - mu) * lax.rsqrt(var + eps)
    return (y * g.astype(jnp.float32) + b.astype(jnp.float32)).astype(x.dtype)


def group_norm(y, eps):
    yf = y.astype(jnp.float32)
    mu = jnp.mean(yf, axis=-1, keepdims=True)
    var = jnp.mean(jnp.square(yf - mu), axis=-1, keepdims=True)
    yn = (yf - mu) * lax.rsqrt(var + eps)
    return yn.reshape(*y.shape[:-2], -1).astype(y.dtype)


def rotary(t, pos):
    half = t.shape[-1] // 2
    inv_freq = ROPE_BASE ** (-jnp.arange(half, dtype=jnp.float32) / half)
    ang = pos.astype(jnp.float32)[:, None] * inv_freq[None, :]
    cos = jnp.cos(ang)[None, :, None, :].astype(t.dtype)
    sin = jnp.sin(ang)[None, :, None, :].astype(t.dtype)
    t1, t2 = t[..., :half], t[..., half:]
    return jnp.concatenate([t1 * cos - t2 * sin, t1 * sin + t2 * cos], axis=-1)


def retention(q, k, v):
    B, S, H, hd = q.shape
    N = S // CHUNK
    dt = q.dtype
    log_gamma = jnp.log(1.0 - 2.0 ** (-5.0 - jnp.arange(H, dtype=jnp.float32)))
    c = jnp.arange(CHUNK, dtype=jnp.float32)
    inner_mask = jnp.exp(log_gamma[:, None, None] * jnp.abs(c[:, None] - c[None, :])).astype(dt)
    k_decay = jnp.exp(log_gamma[:, None] * (CHUNK - 1 - c)).astype(dt)
    q_decay = jnp.exp(log_gamma[:, None] * (c + 1.0)).astype(dt)
    n = jnp.arange(N, dtype=jnp.float32)
    dn = n[:, None] - 1.0 - n[None, :]
    chunk_decay = jnp.where(dn >= 0, jnp.exp(log_gamma[:, None, None] * CHUNK * jnp.maximum(dn, 0.0)), 0.0).astype(dt)
    to_chunks = lambda t: t.reshape(B, N, CHUNK, H, hd).transpose(0, 3, 1, 2, 4)
    qc, kc, vc = to_chunks(q), to_chunks(k * hd ** -0.5), to_chunks(v)
    scores = jnp.einsum('bhncd,bhnmd->bhncm', qc, kc) * inner_mask[:, None]
    inner = jnp.einsum('bhncm,bhnme->bhnce', scores, vc)
    kv = jnp.einsum('bhncd,bhnce->bhnde', kc * k_decay[:, None, :, None], vc)
    state_in = jnp.einsum('hni,bhide->bhnde', chunk_decay, kv)
    cross = jnp.einsum('bhncd,bhnde->bhnce', qc * q_decay[:, None, :, None], state_in)
    y = inner + cross
    return y.transpose(0, 2, 3, 1, 4).reshape(B, S, H, hd)


def token_shift(p, mu):
    prev = jnp.pad(p[:, :-1], ((0, 0), (1, 0), (0, 0)))
    return p + mu * (prev - p)


def rwkv7_time_mix(p, w_up, w0, a_up, a0, g_up, k_k, k_a, r_k, ln_g, ln_b):
    B, S, _ = p.shape
    dt = p.dtype
    r, k, v, dw, da, dg = jnp.split(
        p, [RWKV_W, 2 * RWKV_W, 3 * RWKV_W, 3 * RWKV_W + W_LORA, 3 * RWKV_W + W_LORA + A_LORA], axis=-1)
    w_log = -jax.nn.softplus(-(w0 + jnp.tanh(dw) @ w_up)) - 0.5
    decay = jnp.exp(-jnp.exp(w_log.astype(jnp.float32))).astype(dt)
    a = jax.nn.sigmoid(a0 + da @ a_up)
    g = jax.nn.sigmoid(dg) @ g_up
    heads = lambda t: t.reshape(B, S, RWKV_HEADS, RWKV_HD)
    kk = heads(k * k_k).astype(jnp.float32)
    kk = (kk / jnp.maximum(jnp.linalg.norm(kk, axis=-1, keepdims=True), 1e-12)).astype(dt)
    k = k * (1.0 + (a - 1.0) * k_a)
    r_h, k_h, v_h, a_h, w_h = heads(r), heads(k), heads(v), heads(a), heads(decay)

    def step(state, inp):
        r_t, w_t, k_t, v_t, kk_t, a_t = inp
        sa = jnp.einsum('bhvk,bhk->bhv', state, -kk_t)
        state = (state * w_t[:, :, None, :]
                 + sa[..., None] * (kk_t * a_t)[:, :, None, :]
                 + v_t[..., None] * k_t[:, :, None, :])
        return state, jnp.einsum('bhvk,bhk->bhv', state, r_t)

    time_major = lambda t: jnp.swapaxes(t, 0, 1).astype(dt)
    s0 = jnp.zeros((B, RWKV_HEADS, RWKV_HD, RWKV_HD), dt)
    _, y = lax.scan(step, s0, (time_major(r_h), time_major(w_h), time_major(k_h),
                               time_major(v_h), time_major(kk), time_major(a_h)))
    y = jnp.swapaxes(y, 0, 1)
    y = group_norm(y, RWKV_GN_EPS) * ln_g + ln_b
    bonus = jnp.sum(r_h * k_h * r_k, axis=-1, keepdims=True) * v_h
    return (y + bonus.reshape(B, S, RWKV_W)) * g


def hybrid_mixer(x, w_in, ret_gn_g, rwkv_mu, rwkv_w_up, rwkv_w0, rwkv_a_up, rwkv_a0, rwkv_g_up,
                 rwkv_k_k, rwkv_k_a, rwkv_r_k, rwkv_ln_g, rwkv_ln_b, w_ret_up, w_rwkv_up, w_out):
    B, S, _ = x.shape
    p = x @ w_in
    p_ret = p[..., :RET_COLS]
    p_rwkv = p[..., RET_COLS:RET_COLS + RWKV_COLS]
    p_gate = p[..., RET_COLS + RWKV_COLS:]
    q, k, v, g = jnp.split(p_ret, 4, axis=-1)
    heads = lambda t: t.reshape(B, S, RET_HEADS, RET_HD)
    pos = jnp.arange(S)
    y_ret = retention(rotary(heads(q), pos), rotary(heads(k), pos), heads(v))
    y_ret = jax.nn.silu(g) * (group_norm(y_ret, LN_EPS) * ret_gn_g)
    y_rwkv = rwkv7_time_mix(token_shift(p_rwkv, rwkv_mu), rwkv_w_up, rwkv_w0, rwkv_a_up, rwkv_a0,
                            rwkv_g_up, rwkv_k_k, rwkv_k_a, rwkv_r_k, rwkv_ln_g, rwkv_ln_b)
    gate_ret, gate_rwkv = jnp.split(jax.nn.sigmoid(p_gate), 2, axis=-1)
    merged = gate_ret * (y_ret @ w_ret_up) + gate_rwkv * (y_rwkv @ w_rwkv_up)
    return merged @ w_out


def memory_cross_attention(x, mem, wq, wkv, wo):
    B, S, _ = x.shape
    M = mem.shape[1]
    q = (x @ wq).reshape(B, S, XA_HEADS, XA_HD)
    k, v = jnp.split(mem @ wkv, 2, axis=-1)
    k = k.reshape(B, M, XA_HEADS, XA_HD)
    v = v.reshape(B, M, XA_HEADS, XA_HD)
    s = jnp.einsum('bshd,bmhd->bhsm', q, k).astype(jnp.float32) * XA_HD ** -0.5
    probs = jax.nn.softmax(s, axis=-1).astype(x.dtype)
    o = jnp.einsum('bhsm,bmhd->bshd', probs, v).reshape(B, S, D_MODEL)
    return o @ wo


def grouped_moe(x, router_w, router_bias, w_gate, w_up, w_down):
    B, S, D = x.shape
    t = x.reshape(-1, D)
    affinity = jax.nn.sigmoid((t @ router_w).astype(jnp.float32))
    choice = affinity + router_bias.astype(jnp.float32)
    group_score = jnp.sum(lax.top_k(choice.reshape(-1, N_GROUPS, EXPERTS_PER_GROUP), TOP_K)[0], axis=-1)
    best_group = jnp.argmax(group_score, axis=-1)
    in_group = (jnp.arange(N_EXPERTS) // EXPERTS_PER_GROUP)[None, :] == best_group[:, None]
    _, idx = lax.top_k(jnp.where(in_group, choice, -jnp.inf), TOP_K)
    wts = jnp.take_along_axis(affinity, idx, axis=-1)
    wts = wts / jnp.sum(wts, axis=-1, keepdims=True)
    combine = jnp.sum(jax.nn.one_hot(idx, N_EXPERTS, dtype=jnp.float32) * wts[..., None], axis=1).astype(x.dtype)
    y = jnp.zeros_like(t)
    for e in range(N_EXPERTS):
        h = jax.nn.silu(t @ w_gate[e]) * (t @ w_up[e])
        y = y + combine[:, e:e + 1] * (h @ w_down[e])
    return y.reshape(B, S, D)


def setup_inputs(seed: int = 0) -> dict:
    key = jax.random.key(seed)
    ks = iter(jax.random.split(key, 48))
    nrm = lambda shape, scale: scale * jax.random.normal(next(ks), shape, jnp.float32)
    L = DEPTH
    return {
        'x': nrm((BATCH, SEQ, D_MODEL), 1.0),
        'mem': nrm((BATCH, MEM_LEN, D_MODEL), 1.0),
        'ln_in_g': 1.0 + nrm((D_MODEL,), 0.02),
        'ln_in_b': nrm((D_MODEL,), 0.02),
        'router_w': nrm((D_MODEL, N_EXPERTS), D_MODEL ** -0.5),
        'router_bias': nrm((N_EXPERTS,), 0.01),
        'w_in': nrm((L, D_MODEL, N_IN), D_MODEL ** -0.5),
        'ret_gn_g': 1.0 + nrm((L, RET_W), 0.02),
        'rwkv_mu': jax.random.uniform(next(ks), (L, RWKV_COLS), jnp.float32),
        'rwkv_w_up': nrm((L, W_LORA, RWKV_W), 0.5 * W_LORA ** -0.5),
        'rwkv_w0': jnp.linspace(-6.0, -1.0, RWKV_W, dtype=jnp.float32)[None, :] + nrm((L, RWKV_W), 0.1),
        'rwkv_a_up': nrm((L, A_LORA, RWKV_W), 0.5 * A_LORA ** -0.5),
        'rwkv_a0': nrm((L, RWKV_W), 0.1),
        'rwkv_g_up': nrm((L, G_LORA, RWKV_W), G_LORA ** -0.5),
        'rwkv_k_k': 0.85 + nrm((L, RWKV_W), 0.05),
        'rwkv_k_a': 1.0 + nrm((L, RWKV_W), 0.05),
        'rwkv_r_k': nrm((L, RWKV_HEADS, RWKV_HD), 0.1),
        'rwkv_ln_g': 1.0 + nrm((L, RWKV_W), 0.02),
        'rwkv_ln_b': nrm((L, RWKV_W), 0.02),
        'w_ret_up': nrm((L, RET_W, D_MODEL), RET_W ** -0.5),
        'w_rwkv_up': nrm((L, RWKV_W, D_MODEL), RWKV_W ** -0.5),
        'w_out': nrm((L, D_MODEL, D_MODEL), BETA * D_MODEL ** -0.5),
        'ln1_g': 1.0 + nrm((L, D_MODEL), 0.02),
        'ln1_b': nrm((L, D_MODEL), 0.02),
        'xa_wq': nrm((L, D_MODEL, D_MODEL), D_MODEL ** -0.5),
        'xa_wkv': nrm((L, D_MODEL, 2 * D_MODEL), D_MODEL ** -0.5),
        'xa_wo': nrm((L, D_MODEL, D_MODEL), BETA * D_MODEL ** -0.5),
        'ln2_g': 1.0 + nrm((L, D_MODEL), 0.02),
        'ln2_b': nrm((L, D_MODEL), 0.02),
        'moe_w_gate': nrm((L, N_EXPERTS, D_MODEL, D_EXPERT), D_MODEL ** -0.5),
        'moe_w_up': nrm((L, N_EXPERTS, D_MODEL, D_EXPERT), D_MODEL ** -0.5),
        'moe_w_down': nrm((L, N_EXPERTS, D_EXPERT, D_MODEL), BETA * D_EXPERT ** -0.5),
        'ln3_g': 1.0 + nrm((L, D_MODEL), 0.02),
        'ln3_b': nrm((L, D_MODEL), 0.02),
    }


def reference(x, mem, ln_in_g, ln_in_b, router_w, router_bias, w_in, ret_gn_g, rwkv_mu, rwkv_w_up,
              rwkv_w0, rwkv_a_up, rwkv_a0, rwkv_g_up, rwkv_k_k, rwkv_k_a, rwkv_r_k, rwkv_ln_g, rwkv_ln_b,
              w_ret_up, w_rwkv_up, w_out, ln1_g, ln1_b, xa_wq, xa_wkv, xa_wo, ln2_g, ln2_b,
              moe_w_gate, moe_w_up, moe_w_down, ln3_g, ln3_b):
    x = layer_norm(x, ln_in_g, ln_in_b)
    for l in range(DEPTH):
        h = hybrid_mixer(x, w_in[l], ret_gn_g[l], rwkv_mu[l], rwkv_w_up[l], rwkv_w0[l], rwkv_a_up[l],
                         rwkv_a0[l], rwkv_g_up[l], rwkv_k_k[l], rwkv_k_a[l], rwkv_r_k[l], rwkv_ln_g[l],
                         rwkv_ln_b[l], w_ret_up[l], w_rwkv_up[l], w_out[l])
        x = layer_norm(ALPHA * x + h, ln1_g[l], ln1_b[l])
        h = memory_cross_attention(x, mem, xa_wq[l], xa_wkv[l], xa_wo[l])
        x = layer_norm(ALPHA * x + h, ln2_g[l], ln2_b[l])
        h = grouped_moe(x, router_w, router_bias, moe_w_gate[l], moe_w_up[l], moe_w_down[l])
        x = layer_norm(ALPHA * x + h, ln3_g[l], ln3_b[l])
    return x
```

```cpp
#include <hip/hip_runtime.h>
#include <cstdio>
#include <cstdint>
namespace pg8 {
#define PG8_LAS __attribute__((address_space(3)))
typedef unsigned short bf16_t;
typedef short bf16x8 __attribute__((ext_vector_type(8)));
typedef float f32x4 __attribute__((ext_vector_type(4)));
typedef unsigned u32x4 __attribute__((ext_vector_type(4)));
constexpr int BM = 256, BK = 64, HALF = 128, HTB = HALF * BK * 2  , STAGE_BYTES = 8 * HTB, NXCD = 8, WGM = 8;

__host__ __device__ __forceinline__ int lds_byte(int r, int c) { const int st = (r >> 4) * 2 + (c >> 5), rr = r & 15, cc = c & 31, ob = rr * 64 + cc * 2; return st * 1024 + (ob ^ (((ob >> 9) & 1) << 5)); }
__host__ __device__ __forceinline__ void stage_rc(int b, int& R, int& C) { const int st = b / 1024, sb = b % 1024, swz = sb ^ (((sb >> 9) & 1) << 5); R = (st >> 1) * 16 + swz / 64; C = (st & 1) * 32 + (swz % 64) / 2; }
__host__ __device__ __forceinline__ int perm32(int rho) { const int n = rho >> 4, i = rho & 15; return 8 * (i >> 2) + 4 * n + (i & 3); }

struct Unit { int pm, pn; };
struct Gemm { const bf16_t* A; const bf16_t* Bt; int M, N, K; };

struct StaticOrder {
    int nM, nN, nwg, G, c;
    __host__ __device__ void init(int M, int N, int G_, int c_) { nM = M / BM; nN = N / BM; nwg = nM * nN; G = G_; c = c_; }
    __host__ __device__ bool next(int i, Unit& u) const {
        const long L = (long)i * G + c; if (L >= nwg) return false;
        int wgid = (int)L; { const int q = nwg / NXCD, r = nwg % NXCD, xcd = wgid % NXCD, off = wgid / NXCD; wgid = (xcd < r ? xcd * (q + 1) : r * (q + 1) + (xcd - r) * q) + off; }
        const int nig = WGM * nN, gid = wgid / nig, fm = gid * WGM, gsz = (nM - fm) < WGM ? (nM - fm) : WGM;
        u.pm = fm + ((wgid % nig) % gsz); u.pn = (wgid % nig) / gsz; return true;
    }
    __device__ __forceinline__ void a_ready(const Unit&) const {}
    __device__ __forceinline__ void done(const Unit&) const {}
};

__device__ __forceinline__ unsigned cvt_pk_bf16(float lo, float hi) { unsigned r; asm volatile("v_cvt_pk_bf16_f32 %0, %1, %2" : "=v"(r) : "v"(lo), "v"(hi)); return r; }
typedef float f32x2 __attribute__((ext_vector_type(2)));
__device__ __forceinline__ f32x2 gelu_pk(f32x2 v) {
    const f32x2 av = __builtin_elementwise_abs(v), d = av * 0.2316418882f + 1.0f;
    f32x2 t; t.x = __builtin_amdgcn_rcpf(d.x); t.y = __builtin_amdgcn_rcpf(d.y);
    f32x2 q = t * 0.5307027145f + (-0.7265760135f); q = q * t + 0.7107068705f; q = q * t + (-0.142248368f); q = q * t + 0.127414796f; q = q * t;
    const f32x2 s = (v * v) * (-0.72134752044f);
    f32x2 e; e.x = __builtin_amdgcn_exp2f(s.x); e.y = __builtin_amdgcn_exp2f(s.y);
    const f32x2 m = v * (q * e), r = v - m;
    f32x2 o; o.x = v.x < 0.f ? m.x : r.x; o.y = v.y < 0.f ? m.y : r.y; return o;
}

template <int ACT  > struct EpiBf16 {
    static constexpr bool PERM = true, AFTER_DRAIN = false; static_assert(ACT == 0 || ACT == 1, "EpiBf16: ACT is 0 (none) or 1 (gelu_pk)");
    bf16_t* O; int ldc; const float* bias; int split_cols; size_t split_stride; float scale0;
    __device__ __forceinline__ void operator()(const f32x4 (&acc)[2][2][4][2], const Unit& u, int wr, int wc, int fr, int fq) const {
        const int row0 = u.pm * BM + wr * 64 + fr; int colt = u.pn * BM; bf16_t* base = O;
        float sc = 1.f; if (split_cols) { const int t = colt / split_cols; base += (size_t)t * split_stride; colt -= t * split_cols; if (t == 0) sc = scale0; }
        const int col0 = colt + wc * 32 + 8 * fq, bcol0 = u.pn * BM + wc * 32 + 8 * fq;
        f32x4 bv[2][2];
#pragma unroll
        for (int bj = 0; bj < 2; ++bj)
#pragma unroll
            for (int n = 0; n < 2; ++n) bv[bj][n] = bias ? *(const f32x4*)(bias + bcol0 + bj * HALF + 4 * n) : (f32x4){0.f, 0.f, 0.f, 0.f};
#pragma unroll
        for (int ai = 0; ai < 2; ++ai)
#pragma unroll
            for (int m = 0; m < 4; ++m) { bf16_t* rowp = base + (size_t)(row0 + ai * HALF + m * 16) * ldc + col0;
#pragma unroll
                for (int bj = 0; bj < 2; ++bj) { f32x4 v0 = acc[ai][bj][m][0] + bv[bj][0], v1 = acc[ai][bj][m][1] + bv[bj][1];
                    if (ACT == 1) { f32x2 a = gelu_pk((f32x2){v0[0], v0[1]}), b = gelu_pk((f32x2){v0[2], v0[3]}), c = gelu_pk((f32x2){v1[0], v1[1]}), d = gelu_pk((f32x2){v1[2], v1[3]});
                        v0 = (f32x4){a.x, a.y, b.x, b.y}; v1 = (f32x4){c.x, c.y, d.x, d.y}; }
                    v0 = v0 * sc; v1 = v1 * sc; u32x4 w; w.x = cvt_pk_bf16(v0[0], v0[1]); w.y = cvt_pk_bf16(v0[2], v0[3]); w.z = cvt_pk_bf16(v1[0], v1[1]); w.w = cvt_pk_bf16(v1[2], v1[3]);
                    *(u32x4*)(rowp + bj * HALF) = w; } }
    }
};
__device__ __forceinline__ float sigmoid_f(float x) { return __builtin_amdgcn_rcpf(1.f + __builtin_amdgcn_exp2f(-1.44269504f * x)); }
__device__ __forceinline__ float bf_lo(unsigned w) { return __uint_as_float(w << 16); }
__device__ __forceinline__ float bf_hi(unsigned w) { return __uint_as_float(w & 0xffff0000u); }
typedef unsigned u32x2 __attribute__((ext_vector_type(2)));
enum { EM_BF16 = 0, EM_F32 = 1, EM_MERGE0 = 2, EM_MERGE1 = 3, EM_MOEA = 4 };
struct EpiU {
    static constexpr bool PERM = true, AFTER_DRAIN = false;
    int mode; bf16_t* O0; int ld0; int npn0; bf16_t* O1; int ld1; int pn_mask; int act; float scale; float* F; const bf16_t* G;
    __device__ __forceinline__ void operator()(const f32x4 (&acc)[2][2][4][2], const Unit& u, int wr, int wc, int fr, int fq) const {
        const int row0 = u.pm * BM + wr * 64 + fr;
        if (mode == EM_BF16) {
            int pn = u.pn & pn_mask; bf16_t* base = O0; int ldc = ld0; if (pn >= npn0) { pn -= npn0; base = O1; ldc = ld1; }
            const int col0 = pn * BM + wc * 32 + 8 * fq;
#pragma unroll
            for (int ai = 0; ai < 2; ++ai)
#pragma unroll
                for (int m = 0; m < 4; ++m) { bf16_t* rowp = base + (size_t)(row0 + ai * HALF + m * 16) * ldc + col0;
#pragma unroll
                    for (int bj = 0; bj < 2; ++bj) { f32x4 v0 = acc[ai][bj][m][0], v1 = acc[ai][bj][m][1];
                        if (act == 1) {
#pragma unroll
                            for (int q = 0; q < 4; ++q) { v0[q] = sigmoid_f(v0[q]); v1[q] = sigmoid_f(v1[q]); } }
                        v0 = v0 * scale; v1 = v1 * scale; u32x4 w; w.x = cvt_pk_bf16(v0[0], v0[1]); w.y = cvt_pk_bf16(v0[2], v0[3]); w.z = cvt_pk_bf16(v1[0], v1[1]); w.w = cvt_pk_bf16(v1[2], v1[3]);
                        *(u32x4*)(rowp + bj * HALF) = w; } }
        } else if (mode == EM_MOEA) {
            const int col0 = (u.pn & 3) * HALF + wc * 32 + 8 * fq;
#pragma unroll
            for (int ai = 0; ai < 2; ++ai)
#pragma unroll
                for (int m = 0; m < 4; ++m) { bf16_t* rowp = O0 + (size_t)(row0 + ai * HALF + m * 16) * 512 + col0;
                    f32x4 h0, h1;
#pragma unroll
                    for (int q = 0; q < 4; ++q) { const float g0 = acc[ai][0][m][0][q], g1 = acc[ai][0][m][1][q]; h0[q] = g0 * sigmoid_f(g0) * acc[ai][1][m][0][q]; h1[q] = g1 * sigmoid_f(g1) * acc[ai][1][m][1][q]; }
                    u32x4 w; w.x = cvt_pk_bf16(h0[0], h0[1]); w.y = cvt_pk_bf16(h0[2], h0[3]); w.z = cvt_pk_bf16(h1[0], h1[1]); w.w = cvt_pk_bf16(h1[2], h1[3]);
                    *(u32x4*)rowp = w; }
        } else {
            const int col0 = u.pn * BM + wc * 32 + 8 * fq;
#pragma unroll
            for (int ai = 0; ai < 2; ++ai)
#pragma unroll
                for (int m = 0; m < 4; ++m) { const size_t row = (size_t)(row0 + ai * HALF + m * 16);
#pragma unroll
                    for (int bj = 0; bj < 2; ++bj) { const int c = col0 + bj * HALF; f32x4 v0 = acc[ai][bj][m][0], v1 = acc[ai][bj][m][1];
                        if (mode != EM_F32) { const u32x4 gv = *(const u32x4*)(G + row * 2048 + (mode == EM_MERGE1 ? 1024 : 0) + c);
                            v0 = v0 * (f32x4){bf_lo(gv.x), bf_hi(gv.x), bf_lo(gv.y), bf_hi(gv.y)}; v1 = v1 * (f32x4){bf_lo(gv.z), bf_hi(gv.z), bf_lo(gv.w), bf_hi(gv.w)}; }
                        if (mode == EM_MERGE1) { v0 = v0 + *(const f32x4*)(F + row * 1024 + c); v1 = v1 + *(const f32x4*)(F + row * 1024 + c + 4);
                            u32x4 w; w.x = cvt_pk_bf16(v0[0], v0[1]); w.y = cvt_pk_bf16(v0[2], v0[3]); w.z = cvt_pk_bf16(v1[0], v1[1]); w.w = cvt_pk_bf16(v1[2], v1[3]); *(u32x4*)(O0 + row * 1024 + c) = w; }
                        else { *(f32x4*)(F + row * 1024 + c) = v0; *(f32x4*)(F + row * 1024 + c + 4) = v1; } } }
        }
    }
};
struct OrderU {
    StaticOrder st; int moe; const PG8_LAS int* tp;
    __device__ __forceinline__ bool next(int i, Unit& u) const {
        if (!moe) return st.next(i, u);
        const int L = i * st.G + st.c, tot = tp[16] * 4; if (L >= tot) return false;
        const int mt = L >> 2, nt = L & 3; int e = 0;
#pragma unroll
        for (int q = 1; q < 16; ++q) e += (mt >= tp[q]) ? 1 : 0;
        u.pm = mt; u.pn = e * 4 + nt; return true;
    }
    __device__ __forceinline__ void a_ready(const Unit&) const {}
    __device__ __forceinline__ void done(const Unit&) const {}
};
template <class Epi, class Sched, bool ALIGN_EPI = false, bool SP2 = false>
__device__ __forceinline__ void gemm_phase(PG8_LAS unsigned char* lds, const Gemm g, const Sched& S, const Epi& E) {
    const int tid = threadIdx.x, wid = __builtin_amdgcn_readfirstlane(tid >> 6), lane = tid & 63, wr = wid >> 2, wc = wid & 3, fr = lane & 15, fq = lane >> 4;
    const int K = g.K, nt = K / BK;
    unsigned voffA[2], voffB[2];
#pragma unroll
    for (int i = 0; i < 2; ++i) { int R, C; stage_rc(tid * 16 + i * 8192, R, C); const int Rb = Epi::PERM ? ((R & ~31) + perm32(R & 31)) : R;
        voffA[i] = (unsigned)(R * K + C) * 2u; voffB[i] = (unsigned)(Rb * K + C) * 2u; }
    const size_t kstep = (size_t)(BK * 2);
    const size_t hstep = (size_t)HALF * K * 2;
    const size_t tstep = 2 * hstep;
    const unsigned ldsw = (unsigned)wid * 1024u;
    const int aoff = lds_byte(wr * 64 + fr, fq * 8), boff = lds_byte(wc * 32 + fr, fq * 8);
#define PG8_SA(b, h) (((b) * 2 + (h)) * HTB)
#define PG8_SB(b, h) ((4 + (b) * 2 + (h)) * HTB)
#define PG8_STAGE(bufoff, gbase, voff) do { _Pragma("unroll") for (int _i = 0; _i < 2; ++_i) \
        __builtin_amdgcn_global_load_lds((const unsigned*)((const char*)(gbase) + (voff)[_i]), (PG8_LAS unsigned*)(lds + (bufoff) + ldsw + _i * 8192), 16, 0, 0); } while (0)
#define PG8_LDA(dst, b, h) do { _Pragma("unroll") for (int m = 0; m < 4; ++m) _Pragma("unroll") for (int k = 0; k < 2; ++k) dst[m][k] = *(const PG8_LAS bf16x8*)(lds + PG8_SA(b, h) + aoff + m * 2048 + k * 1024); } while (0)
#define PG8_LDB(dst, b, h) do { _Pragma("unroll") for (int n = 0; n < 2; ++n) _Pragma("unroll") for (int k = 0; k < 2; ++k) dst[n][k] = *(const PG8_LAS bf16x8*)(lds + PG8_SB(b, h) + boff + n * 2048 + k * 1024); } while (0)
#define PG8_MMA(ai, bj, At, Bt) do { __builtin_amdgcn_s_setprio(1); _Pragma("unroll") for (int m = 0; m < 4; ++m) _Pragma("unroll") for (int n = 0; n < 2; ++n) _Pragma("unroll") for (int k = 0; k < 2; ++k) \
        acc[ai][bj][m][n] = __builtin_amdgcn_mfma_f32_16x16x32_bf16(Bt[n][k], At[m][k], acc[ai][bj][m][n], 0, 0, 0); __builtin_amdgcn_s_setprio(0); } while (0)
#define PG8_WAIT_V(n) asm volatile("s_waitcnt vmcnt(" #n ")" ::: "memory")
#define PG8_WAIT_L(n) asm volatile("s_waitcnt lgkmcnt(" #n ")" ::: "memory")
#define PG8_BAR __builtin_amdgcn_s_barrier()
#define PG8_SCHED __builtin_amdgcn_sched_barrier(0)
    Unit cur, nxt; int ui = 0;
    if (!S.next(0, cur)) return;
    f32x4 acc[2][2][4][2];
#pragma unroll
    for (int a = 0; a < 2; ++a)
#pragma unroll
        for (int b = 0; b < 2; ++b)
#pragma unroll
            for (int m = 0; m < 4; ++m)
#pragma unroll
                for (int n = 0; n < 2; ++n) acc[a][b][m][n] = (f32x4){0.f, 0.f, 0.f, 0.f};
    bf16x8 At[4][2], B0[2][2], B1[2][2];
    const char* cA = (const char*)g.A + (size_t)cur.pm * tstep; const char* cB = (const char*)g.Bt + (size_t)cur.pn * tstep;
    S.a_ready(cur);
    if constexpr (SP2) {
        PG8_STAGE(PG8_SB(0, 0), cB, voffB); PG8_STAGE(PG8_SB(0, 1), cB + hstep, voffB); PG8_STAGE(PG8_SA(0, 0), cA, voffA); PG8_STAGE(PG8_SA(0, 1), cA + hstep, voffA);
        if (wr == 1) PG8_BAR;
        PG8_WAIT_V(2); PG8_BAR;
        PG8_STAGE(PG8_SB(1, 0), cB + kstep, voffB); PG8_STAGE(PG8_SA(1, 0), cA + kstep, voffA); PG8_STAGE(PG8_SB(1, 1), cB + hstep + kstep, voffB);
        PG8_WAIT_V(6); PG8_BAR;
    } else {
        PG8_STAGE(PG8_SB(0, 0), cB, voffB); PG8_STAGE(PG8_SA(0, 0), cA, voffA); PG8_STAGE(PG8_SB(0, 1), cB + hstep, voffB); PG8_STAGE(PG8_SA(0, 1), cA + hstep, voffA);
        if (wr == 1) PG8_BAR;
        PG8_WAIT_V(4); PG8_BAR;
        PG8_STAGE(PG8_SB(1, 0), cB + kstep, voffB); PG8_STAGE(PG8_SA(1, 0), cA + kstep, voffA); PG8_STAGE(PG8_SB(1, 1), cB + hstep + kstep, voffB);
        PG8_WAIT_V(6); PG8_BAR;
    }
    for (;;) {
        const bool has_next = S.next(ui + 1, nxt);
        const char* nA = has_next ? (const char*)g.A + (size_t)nxt.pm * tstep : cA; const char* nB = has_next ? (const char*)g.Bt + (size_t)nxt.pn * tstep : cB;
        for (int t = 0; t < nt; t += 2) {
            const bool last = (t == nt - 2);
            const char* a1 = cA + (size_t)(t + 1) * kstep;
            const char* a2 = last ? nA : cA + (size_t)(t + 2) * kstep; const char* b2 = last ? nB : cB + (size_t)(t + 2) * kstep;
            const char* a3 = a2 + kstep; const char* b3 = b2 + kstep;
            if (last && has_next) S.a_ready(nxt);
            if constexpr (SP2) {
            PG8_LDB(B0, 0, 0); PG8_LDB(B1, 0, 1); PG8_SCHED; PG8_LDA(At, 0, 0); PG8_STAGE(PG8_SA(1, 1), a1 + hstep, voffA);
            PG8_WAIT_V(8); PG8_WAIT_L(0); PG8_BAR; PG8_MMA(0, 0, At, B0); PG8_MMA(0, 1, At, B1); PG8_BAR; PG8_SCHED;
            PG8_LDA(At, 0, 1); PG8_STAGE(PG8_SB(0, 0), b2, voffB); PG8_STAGE(PG8_SB(0, 1), b2 + hstep, voffB); PG8_STAGE(PG8_SA(0, 0), a2, voffA);
            PG8_WAIT_V(8); PG8_WAIT_L(0); PG8_BAR; PG8_MMA(1, 0, At, B0); PG8_MMA(1, 1, At, B1); PG8_BAR; PG8_SCHED;
            PG8_LDB(B0, 1, 0); PG8_LDB(B1, 1, 1); PG8_SCHED; PG8_LDA(At, 1, 0); PG8_STAGE(PG8_SA(0, 1), a2 + hstep, voffA);
            PG8_WAIT_V(8); PG8_WAIT_L(0); PG8_BAR; PG8_MMA(0, 0, At, B0); PG8_MMA(0, 1, At, B1); PG8_BAR; PG8_SCHED;
            PG8_LDA(At, 1, 1); PG8_STAGE(PG8_SB(1, 0), b3, voffB); PG8_STAGE(PG8_SB(1, 1), b3 + hstep, voffB); PG8_STAGE(PG8_SA(1, 0), a3, voffA);
            PG8_WAIT_V(8); PG8_WAIT_L(0); PG8_BAR; PG8_MMA(1, 0, At, B0); PG8_MMA(1, 1, At, B1); PG8_BAR; PG8_SCHED;
            } else {
            PG8_LDB(B0, 0, 0); PG8_SCHED; PG8_LDA(At, 0, 0); PG8_STAGE(PG8_SA(1, 1), a1 + hstep, voffA);
            PG8_WAIT_L(8); PG8_BAR; PG8_WAIT_L(0); PG8_MMA(0, 0, At, B0); PG8_BAR; PG8_SCHED;
            PG8_LDB(B1, 0, 1); PG8_STAGE(PG8_SB(0, 0), b2, voffB);
            PG8_BAR; PG8_WAIT_L(0); PG8_MMA(0, 1, At, B1); PG8_BAR;
            PG8_LDA(At, 0, 1); PG8_STAGE(PG8_SA(0, 0), a2, voffA);
            PG8_BAR; PG8_WAIT_L(0); PG8_MMA(1, 0, At, B0); PG8_BAR; PG8_SCHED;
            PG8_STAGE(PG8_SB(0, 1), b2 + hstep, voffB);
            PG8_WAIT_V(6); PG8_BAR; PG8_MMA(1, 1, At, B1); PG8_BAR;
            PG8_LDB(B0, 1, 0); PG8_SCHED; PG8_LDA(At, 1, 0); PG8_STAGE(PG8_SA(0, 1), a2 + hstep, voffA);
            PG8_WAIT_L(8); PG8_BAR; PG8_WAIT_L(0); PG8_MMA(0, 0, At, B0); PG8_BAR; PG8_SCHED;
            PG8_LDB(B1, 1, 1); PG8_STAGE(PG8_SB(1, 0), b3, voffB);
            PG8_BAR; PG8_WAIT_L(0); PG8_MMA(0, 1, At, B1); PG8_BAR;
            PG8_LDA(At, 1, 1); PG8_STAGE(PG8_SA(1, 0), a3, voffA);
            PG8_BAR; PG8_WAIT_L(0); PG8_MMA(1, 0, At, B0); PG8_BAR; PG8_SCHED;
            PG8_STAGE(PG8_SB(1, 1), b3 + hstep, voffB);
            PG8_WAIT_V(6); PG8_BAR; PG8_MMA(1, 1, At, B1); PG8_BAR;
            }
        }
        if constexpr (ALIGN_EPI) { if (wr == 0) PG8_BAR; }
        if constexpr (!Epi::AFTER_DRAIN) { E(acc, cur, wr, wc, fr, fq); S.done(cur); }
        if (!has_next) break;
#pragma unroll
        for (int a = 0; a < 2; ++a)
#pragma unroll
            for (int b = 0; b < 2; ++b)
#pragma unroll
                for (int m = 0; m < 4; ++m)
#pragma unroll
                    for (int n = 0; n < 2; ++n) acc[a][b][m][n] = (f32x4){0.f, 0.f, 0.f, 0.f};
        cur = nxt; cA = nA; cB = nB; ++ui;
        if constexpr (ALIGN_EPI) { if (wr == 1) PG8_BAR; }
    }
    PG8_WAIT_V(0);
    if constexpr (!ALIGN_EPI) { if (wr == 0) PG8_BAR; }
    PG8_BAR;
    if constexpr (Epi::AFTER_DRAIN) { E.fused(acc, cur, wr, wc, fr, fq, lds, wid, lane); S.done(cur); }
#undef PG8_SA
#undef PG8_SB
#undef PG8_STAGE
#undef PG8_LDA
#undef PG8_LDB
#undef PG8_MMA
#undef PG8_WAIT_V
#undef PG8_WAIT_L
#undef PG8_BAR
#undef PG8_SCHED
}
}
constexpr int NWAVES = 8;
constexpr int BATCH = 8, SEQ = 2048, T = BATCH * SEQ, D = 1024, DEPTH = 2;
constexpr int RET_H = 4, RET_HD = 128, RET_W = 512, CHUNK = 64, NCHUNK = SEQ / CHUNK;
constexpr int RW_H = 8, RW_HD = 64, RW_W = 512, RW_COLS = 1792;
constexpr int N_IN = 5888, N1 = 3840, NGATE = 2048;
constexpr int MEM_LEN = 256, MEMT = BATCH * MEM_LEN, XA_H = 4, XA_HD = 256;
constexpr int NE = 16, DE = 512;
constexpr float ALPHA = 1.41421356237f;
constexpr float LN_EPS = 1e-5f, RW_GN_EPS = 64e-5f;
constexpr int N_PHASES = 1 + 15 * DEPTH;
#ifndef MK_ONE_LAUNCH
#define MK_ONE_LAUNCH 1
#endif

constexpr size_t MiB = 1u << 20;
constexpr size_t WS_CTL = 0, CTL_ZERO_BYTES = 1 * MiB;
constexpr size_t WS_ROPE = 1 * MiB;
constexpr size_t WS_LISTS = 2 * MiB;
constexpr size_t WS_TOKINFO = 3 * MiB;
constexpr size_t WS_RB = 3 * MiB + 512 * 1024;
constexpr size_t WS_MEMB = 4 * MiB;
constexpr size_t WS_WIN = 8 * MiB;
constexpr size_t WS_WRU = WS_WIN + (size_t)N_IN * D * 2;
constexpr size_t WS_WKU = WS_WRU + MiB;
constexpr size_t WS_WOUT = WS_WKU + MiB;
constexpr size_t WS_WQ = WS_WOUT + 2 * MiB;
constexpr size_t WS_WKV = WS_WQ + 2 * MiB;
constexpr size_t WS_WO = WS_WKV + 4 * MiB;
constexpr size_t WS_MK = 32 * MiB;
constexpr size_t WS_VT = 36 * MiB;
constexpr size_t WS_XN = 40 * MiB;
constexpr size_t AR = 72 * MiB;
constexpr size_t WS_PRET = AR, WS_PRW = AR + 64 * MiB, WS_SI = AR + 120 * MiB, WS_YR = AR + 216 * MiB, WS_YK = AR + 232 * MiB, WS_G = AR + 248 * MiB;
constexpr size_t WS_YRAW = AR, WS_PGATE = AR + 32 * MiB, WS_MRG = AR + 96 * MiB, WS_M1 = AR + 128 * MiB, WS_H1 = AR;
constexpr size_t WS_WMA = AR + 160 * MiB, WS_WMB = AR + 192 * MiB;
constexpr size_t WS_Q = AR + 64 * MiB, WS_O = AR + 96 * MiB;
constexpr size_t WS_XG = AR, WS_HM = AR + 72 * MiB, WS_YM = AR;
constexpr size_t WS_END = AR + 264 * MiB;
static_assert(WS_WO + 2 * MiB <= WS_MK, "ws map");
constexpr int MOE_MAXROWS = 2 * T + NE * 256;
static_assert((size_t)MOE_MAXROWS * 1024 * 2 <= 72 * MiB && (size_t)MOE_MAXROWS * 512 * 2 <= 36 * MiB, "moe buffers");
constexpr int CW_TMO = 0, CW_CODE = 1, CW_BAR = 4096, CW_CNT = 8192;

constexpr int LDS_BYTES = 147456, MISC_OFF = LDS_BYTES - 512;
#define GAS __attribute__((address_space(1)))
#define LAS __attribute__((address_space(3)))
typedef unsigned short bf16;
typedef unsigned v4u __attribute__((ext_vector_type(4)));
typedef float f32x4 __attribute__((ext_vector_type(4)));
typedef short bf16x8 __attribute__((ext_vector_type(8)));
typedef GAS unsigned gu32;
typedef GAS unsigned long long gu64;
#define RLX_AGENT __ATOMIC_RELAXED, __HIP_MEMORY_SCOPE_AGENT
#define LDS_WAIT() asm volatile("s_waitcnt lgkmcnt(0)" ::: "memory")
#define VM_WAIT() asm volatile("s_waitcnt vmcnt(0)" ::: "memory")
__device__ __forceinline__ unsigned long long rt() { return __builtin_amdgcn_s_memrealtime(); }
__device__ __forceinline__ unsigned f2bf(float f) { unsigned u = __builtin_bit_cast(unsigned, f); return (u + 0x7fffu + ((u >> 16) & 1u)) >> 16; }
__device__ __forceinline__ unsigned pk2(float lo, float hi) { return f2bf(lo) | (f2bf(hi) << 16); }

#define XB_TMO      128
#define XB_XCNT(j)  (256  + 64 * (j))
#define XB_XSUB(j)  (1280 + 64 * (j))
#define XB_XGEN(j)  (2304 + 64 * (j))
#define XB_TOP      3328
#define XB_TOPGEN   3392
#define XCD_BAR_WORDS 3456
#define XB_SPIN_CAP (1u << 18)

__device__ __forceinline__ unsigned xb_ld(unsigned* p)              { return __hip_atomic_load(p, __ATOMIC_RELAXED, __HIP_MEMORY_SCOPE_AGENT); }
__device__ __forceinline__ unsigned xb_add(unsigned* p, unsigned v) { return __hip_atomic_fetch_add(p, v, __ATOMIC_RELAXED, __HIP_MEMORY_SCOPE_AGENT); }
__device__ __forceinline__ unsigned xb_xcc_id() { return (unsigned)__builtin_amdgcn_s_getreg((3 << 11) | 20) & 0xFu; }
#define XB_SPIN(cond, bar) do { unsigned _sp = 0; while (cond) { __builtin_amdgcn_s_sleep(1); \
    if ((++_sp & 255u) == 0u) { if (xb_ld(&(bar)[XB_TMO])) break; if (_sp > XB_SPIN_CAP) { atomicAdd(&(bar)[XB_TMO], 1u); break; } } } } while (0)

struct XcdBarrier {
    unsigned* bar; unsigned x;
    volatile LAS unsigned* st;
};

__device__ __forceinline__ XcdBarrier xcd_barrier_post(unsigned* bar, volatile LAS unsigned* st) {
    XcdBarrier b; b.bar = bar; b.x = xb_xcc_id(); b.st = st;
    if (threadIdx.x == 0) (void)xb_add(&bar[XB_XCNT(b.x)], 1u);
    return b;
}
__device__ __forceinline__ void xcd_barrier_complete(unsigned* bar, unsigned x, unsigned& nloc, unsigned& nx) {
    const unsigned G = gridDim.x * gridDim.y * gridDim.z;
    unsigned sum, cnt, mine, sp = 0u;
    for (;;) {
        sum = 0u; cnt = 0u; mine = 0u;
#pragma unroll
        for (unsigned j = 0; j < 16; ++j) { const unsigned c = xb_ld(&bar[XB_XCNT(j)]); sum += c; cnt += (c > 0u) ? 1u : 0u; mine = (j == x) ? c : mine; }
        if (sum == G) break;
        __builtin_amdgcn_s_sleep(1);
        if ((++sp & 255u) == 0u) { if (xb_ld(&bar[XB_TMO])) break; if (sp > XB_SPIN_CAP) { atomicAdd(&bar[XB_TMO], 1u); break; } }
    }
    nloc = mine > 0u ? mine : 1u; nx = cnt > 0u ? cnt : 1u;
}

__device__ __forceinline__ void xcd_barrier(const XcdBarrier& b) {
    asm volatile("s_waitcnt vmcnt(0)" ::: "memory");
    __syncthreads();
    if (threadIdx.x == 0) {
        unsigned* bar = b.bar;
        __builtin_amdgcn_s_waitcnt(0);
        unsigned nloc = b.st[0], nx = b.st[1];
        if (nloc == 0u) { xcd_barrier_complete(bar, b.x, nloc, nx); b.st[0] = nloc; b.st[1] = nx; }
        const unsigned old = xb_add(&bar[XB_XSUB(b.x)], 1u);
        const unsigned gen = old / nloc;
        if (old + 1u == (gen + 1u) * nloc) {
            __builtin_amdgcn_fence(__ATOMIC_RELEASE, "agent");
            asm volatile("s_waitcnt vmcnt(0)" ::: "memory");
            const unsigned og = xb_add(&bar[XB_TOP], 1u);
            const unsigned tg = og / nx;
            if (og + 1u == (tg + 1u) * nx) xb_add(&bar[XB_TOPGEN], 1u);
            else XB_SPIN(xb_ld(&bar[XB_TOPGEN]) == tg, bar);
            __builtin_amdgcn_fence(__ATOMIC_ACQUIRE, "agent");
            xb_add(&bar[XB_XGEN(b.x)], 1u);
            asm volatile("s_waitcnt vmcnt(0)" ::: "memory");
        } else {
            XB_SPIN(xb_ld(&bar[XB_XGEN(b.x)]) == gen, bar);
            __builtin_amdgcn_fence(__ATOMIC_ACQUIRE, "agent");
            asm volatile("s_waitcnt vmcnt(0)" ::: "memory");
        }
    }
    __syncthreads();
}
typedef unsigned u32x2 __attribute__((ext_vector_type(2)));
struct Args { const float* in[34]; float* out; unsigned char* ws; int ph_lo, ph_hi; };
typedef const __attribute__((address_space(4))) Args* KArgs;
#define IN(i) (A->in[i])
struct Frame {
    LAS unsigned char* lds; volatile LAS unsigned* MISC; gu32* ctl;
    int tid, lane, wave, vcu, G;
    float* X; unsigned char* ws;
};
__device__ __forceinline__ float wave_sum(float v) {
#pragma unroll
    for (int o = 1; o < 64; o <<= 1) v += __shfl_xor(v, o);
    return v;
}
#define DPP_F(x, ctrl) __int_as_float(__builtin_amdgcn_update_dpp(0, __float_as_int(x), (ctrl), 0xF, 0xF, true))
__device__ __forceinline__ float row_sum16(float x) {
    x += DPP_F(x, 0xB1); x += DPP_F(x, 0x4E); x += DPP_F(x, 0x141); x += DPP_F(x, 0x140); return x;
}
__device__ __forceinline__ float row_sum8(float x) {
    x += DPP_F(x, 0xB1); x += DPP_F(x, 0x4E); x += DPP_F(x, 0x141); return x;
}
__device__ __forceinline__ float sigm(float x) { return __builtin_amdgcn_rcpf(1.f + __builtin_amdgcn_exp2f(-1.44269504f * x)); }
__device__ __forceinline__ float bfl(unsigned w) { return __uint_as_float(w << 16); }
__device__ __forceinline__ float bfh(unsigned w) { return __uint_as_float(w & 0xffff0000u); }
__device__ __forceinline__ float bf1(bf16 h) { return __uint_as_float((unsigned)h << 16); }

__device__ __forceinline__ void transpose_block(const float* W, int ldw, int k0, int n0, bf16* WT, int ldt, int drow0, LAS float* scr, int lane) {
#pragma unroll 8
    for (int i = 0; i < 32; ++i) { const int kk = 2 * i + (lane >> 5); scr[kk * 33 + (lane & 31)] = W[(size_t)(k0 + kk) * ldw + n0 + (lane & 31)]; }
    LDS_WAIT(); asm volatile("" ::: "memory");
    const int c = lane & 7;
#pragma unroll
    for (int j = 0; j < 4; ++j) { const int n = (lane >> 3) + 8 * j; const LAS float* s = scr + (8 * c) * 33 + n;
        v4u o; o.x = pk2(s[0 * 33], s[1 * 33]); o.y = pk2(s[2 * 33], s[3 * 33]); o.z = pk2(s[4 * 33], s[5 * 33]); o.w = pk2(s[6 * 33], s[7 * 33]);
        *(GAS v4u*)(WT + (size_t)(drow0 + n) * ldt + k0 + 8 * c) = o; }
    LDS_WAIT(); asm volatile("" ::: "memory");
}
__device__ __forceinline__ void convert_wa(KArgs A, Frame& F, int l) {
    LAS float* scr = (LAS float*)(F.lds + F.wave * 16384);
    const int gw = F.vcu * NWAVES + F.wave, NGW = F.G * NWAVES;
    constexpr int I0 = 16 * 184, I1 = 8 * 32, I3 = 16 * 32, I5 = 16 * 64;
    constexpr int NIT = I0 + 2 * I1 + 3 * I3 + I5;
    for (int it = gw; it < NIT; it += NGW) {
        int r = it; const float* W; int K, N; bf16* dst;
        if (r < I0) { W = IN(6) + (size_t)l * D * N_IN; K = D; N = N_IN; dst = (bf16*)(F.ws + WS_WIN); }
        else if ((r -= I0) < I1) { W = IN(19) + (size_t)l * RET_W * D; K = RET_W; N = D; dst = (bf16*)(F.ws + WS_WRU); }
        else if ((r -= I1) < I1) { W = IN(20) + (size_t)l * RW_W * D; K = RW_W; N = D; dst = (bf16*)(F.ws + WS_WKU); }
        else if ((r -= I1) < I3) { W = IN(21) + (size_t)l * D * D; K = D; N = D; dst = (bf16*)(F.ws + WS_WOUT); }
        else if ((r -= I3) < I3) { W = IN(24) + (size_t)l * D * D; K = D; N = D; dst = (bf16*)(F.ws + WS_WQ); }
        else if ((r -= I3) < I5) { W = IN(25) + (size_t)l * D * 2 * D; K = D; N = 2 * D; dst = (bf16*)(F.ws + WS_WKV); }
        else { r -= I5; W = IN(26) + (size_t)l * D * D; K = D; N = D; dst = (bf16*)(F.ws + WS_WO); }
        const int nblk = N / 32, kb = r / nblk, nb = r % nblk;
        transpose_block(W, N, 64 * kb, 32 * nb, dst, K, 32 * nb, scr, F.lane);
    }
}
__device__ __forceinline__ void convert_wm(KArgs A, Frame& F, int l) {
    LAS float* scr = (LAS float*)(F.lds + F.wave * 16384);
    const int gw = F.vcu * NWAVES + F.wave, NGW = F.G * NWAVES;
    constexpr int IE = 256;
    for (int it = gw; it < NE * 3 * IE; it += NGW) {
        const int e = it / (3 * IE), r3 = it % (3 * IE), which = r3 / IE, r = r3 % IE;
        if (which < 2) {
            const float* W = (which == 0 ? IN(29) : IN(30)) + ((size_t)l * NE + e) * D * DE;
            const int kb = r / 16, nb = r % 16, n0 = 32 * nb;
            const int drow0 = e * 1024 + (n0 >> 7) * 256 + which * 128 + (n0 & 127);
            transpose_block(W, DE, 64 * kb, n0, (bf16*)(F.ws + WS_WMA), D, drow0, scr, F.lane);
        } else {
            const float* W = IN(31) + ((size_t)l * NE + e) * DE * D;
            const int kb = r / 32, nb = r % 32, n0 = 32 * nb;
            transpose_block(W, D, 64 * kb, n0, (bf16*)(F.ws + WS_WMB), DE, e * 1024 + n0, scr, F.lane);
        }
    }
}
__device__ __forceinline__ void ln_store(f32x4 (&v)[4], const float* g, const float* b, float* xo, bf16* xn, int lane) {
    float s = 0.f;
#pragma unroll
    for (int j = 0; j < 4; ++j) s += (v[j].x + v[j].y) + (v[j].z + v[j].w);
    const float mean = wave_sum(s) * (1.f / D); float s2 = 0.f;
#pragma unroll
    for (int j = 0; j < 4; ++j) { v[j] = v[j] - mean; s2 += (v[j].x * v[j].x + v[j].y * v[j].y) + (v[j].z * v[j].z + v[j].w * v[j].w); }
    const float rstd = 1.f / sqrtf(wave_sum(s2) * (1.f / D) + LN_EPS);
#pragma unroll
    for (int j = 0; j < 4; ++j) { const f32x4 gg = *(const f32x4*)(g + 4 * lane + 256 * j), bb = *(const f32x4*)(b + 4 * lane + 256 * j);
        v[j] = v[j] * rstd * gg + bb;
        *(f32x4*)(xo + 4 * lane + 256 * j) = v[j];
        u32x2 w; w.x = pk2(v[j].x, v[j].y); w.y = pk2(v[j].z, v[j].w); *(u32x2*)(xn + 4 * lane + 256 * j) = w; }
}
__device__ __forceinline__ void p0_prologue(KArgs A, Frame& F) {
    convert_wa(A, F, 0);
    const int gw = F.vcu * NWAVES + F.wave, NGW = F.G * NWAVES, lane = F.lane;
    for (int m = gw; m < T; m += NGW) {
        const float* xr = IN(0) + (size_t)m * D; f32x4 v[4];
#pragma unroll
        for (int j = 0; j < 4; ++j) v[j] = *(const f32x4*)(xr + 4 * lane + 256 * j);
        ln_store(v, IN(2), IN(3), F.X + (size_t)m * D, (bf16*)(F.ws + WS_XN) + (size_t)m * D, lane);
    }
    for (int m = gw; m < MEMT; m += NGW) {
        const float* xr = IN(1) + (size_t)m * D; bf16* o = (bf16*)(F.ws + WS_MEMB) + (size_t)m * D;
#pragma unroll
        for (int j = 0; j < 4; ++j) { const f32x4 v = *(const f32x4*)(xr + 4 * lane + 256 * j); u32x2 w; w.x = pk2(v.x, v.y); w.y = pk2(v.z, v.w); *(u32x2*)(o + 4 * lane + 256 * j) = w; }
    }
    float* ctab = (float*)(F.ws + WS_ROPE); float* stab = ctab + SEQ * 64;
    for (int i = blockIdx.x * (NWAVES * 64) + F.tid; i < SEQ * 64; i += F.G * NWAVES * 64) {
        const int pos = i >> 6, j = i & 63;
        const float invf = exp2f(-(float)j * (13.287712379549449f / 64.f));
        const double rev = (double)((float)pos * invf) * 0.15915494309189535;
        const float fr = (float)(rev - floor(rev));
        ctab[i] = __builtin_amdgcn_cosf(fr); stab[i] = __builtin_amdgcn_sinf(fr);
    }
}

__device__ __forceinline__ void rwkv_prep(KArgs A, Frame& F, int l, int bi, int nb) {
    const int tid = F.tid, lane = F.lane;
    const int cb = bi & 3;
    LAS bf16* wl = (LAS bf16*)F.lds; LAS float* act = (LAS float*)(F.lds + 65536);
    const float* wup = IN(9) + (size_t)l * 64 * RW_W; const float* aup = IN(11) + (size_t)l * 64 * RW_W; const float* gup = IN(13) + (size_t)l * 128 * RW_W;
    for (int i = tid; i < 256 * 128; i += NWAVES * 64) { const int k = i >> 7, c = i & 127;
        const float v = (k < 64) ? wup[(size_t)k * RW_W + 128 * cb + c] : (k < 128) ? aup[(size_t)(k - 64) * RW_W + 128 * cb + c] : gup[(size_t)(k - 128) * RW_W + 128 * cb + c];
        wl[i] = (bf16)f2bf(v); }
    const bf16* P = (const bf16*)(F.ws + WS_PRW);
    const float* mu = IN(8) + (size_t)l * RW_COLS;
    const float* w0 = IN(10) + (size_t)l * RW_W; const float* a0 = IN(12) + (size_t)l * RW_W;
    const float* k_k = IN(14) + (size_t)l * RW_W; const float* k_a = IN(15) + (size_t)l * RW_W; const float* r_k = IN(16) + (size_t)l * RW_W;
    bf16* SI = (bf16*)(F.ws + WS_SI); bf16* Gb = (bf16*)(F.ws + WS_G); float* RB = (float*)(F.ws + WS_RB);
    const int cg = tid & 31, tg = tid >> 5;
    for (int tt = (bi >> 2); tt < T / 64; tt += (nb >> 2)) {
        __syncthreads();
        {
            const int c = tid >> 3, p = tid & 7; const int t = 64 * tt + c; const bool first = (t & (SEQ - 1)) == 0;
            const bf16* pr = P + (size_t)t * RW_COLS + 1536 + 32 * p; const bf16* pp = pr - RW_COLS;
#pragma unroll 1
            for (int q = 0; q < 4; ++q) {
                const v4u a = *(const v4u*)(pr + 8 * q); v4u b = {0u, 0u, 0u, 0u}; if (!first) b = *(const v4u*)(pp + 8 * q);
                const unsigned aw[4] = {a.x, a.y, a.z, a.w}, bw[4] = {b.x, b.y, b.z, b.w};
#pragma unroll
                for (int z = 0; z < 8; ++z) { const int i = 32 * p + 8 * q + z;
                    const float cur = (z & 1) ? bfh(aw[z >> 1]) : bfl(aw[z >> 1]), prv = (z & 1) ? bfh(bw[z >> 1]) : bfl(bw[z >> 1]);
                    float x = cur + mu[1536 + i] * (prv - cur);
                    if (i < 64) { const float e2 = __builtin_amdgcn_exp2f(2.f * 1.44269504f * x); x = 1.f - 2.f * __builtin_amdgcn_rcpf(e2 + 1.f); }
                    else if (i >= 128) x = __builtin_amdgcn_rcpf(1.f + __builtin_amdgcn_exp2f(-1.44269504f * x));
                    act[i * 64 + c] = x; }
            }
        }
        __syncthreads();
        float ww[4][4], aa[4][4], gg[4][4];
#pragma unroll
        for (int a = 0; a < 4; ++a)
#pragma unroll
            for (int b = 0; b < 4; ++b) { ww[a][b] = 0.f; aa[a][b] = 0.f; gg[a][b] = 0.f; }
#pragma unroll 4
        for (int k = 0; k < 64; ++k) {
            const f32x4 x1 = *(const LAS f32x4*)(act + k * 64 + 4 * tg), x2 = *(const LAS f32x4*)(act + (64 + k) * 64 + 4 * tg);
            const u32x2 w1 = *(const LAS u32x2*)(wl + k * 128 + 4 * cg), w2 = *(const LAS u32x2*)(wl + (64 + k) * 128 + 4 * cg);
            const float c1[4] = {bfl(w1.x), bfh(w1.x), bfl(w1.y), bfh(w1.y)}, c2[4] = {bfl(w2.x), bfh(w2.x), bfl(w2.y), bfh(w2.y)};
#pragma unroll
            for (int a = 0; a < 4; ++a)
#pragma unroll
                for (int b = 0; b < 4; ++b) { ww[a][b] += x1[a] * c1[b]; aa[a][b] += x2[a] * c2[b]; }
        }
#pragma unroll 4
        for (int k = 0; k < 128; ++k) {
            const f32x4 x3 = *(const LAS f32x4*)(act + (128 + k) * 64 + 4 * tg);
            const u32x2 w3 = *(const LAS u32x2*)(wl + (128 + k) * 128 + 4 * cg);
            const float c3[4] = {bfl(w3.x), bfh(w3.x), bfl(w3.y), bfh(w3.y)};
#pragma unroll
            for (int a = 0; a < 4; ++a)
#pragma unroll
                for (int b = 0; b < 4; ++b) gg[a][b] += x3[a] * c3[b];
        }
        const int col0 = 128 * cb + 4 * cg, h = col0 >> 6, kidx = col0 & 63;
        __syncthreads();
        {
            const f32x4 w0v = *(const f32x4*)(w0 + col0), a0v = *(const f32x4*)(a0 + col0);
#pragma unroll
            for (int a = 0; a < 4; ++a) {
                *(LAS f32x4*)(act + (4 * tg + a) * 128 + 4 * cg) = (f32x4){ww[a][0] + w0v[0], ww[a][1] + w0v[1], ww[a][2] + w0v[2], ww[a][3] + w0v[3]};
                *(LAS f32x4*)(act + 8192 + (4 * tg + a) * 128 + 4 * cg) = (f32x4){aa[a][0] + a0v[0], aa[a][1] + a0v[1], aa[a][2] + a0v[2], aa[a][3] + a0v[3]};
                u32x2 o; o.x = pk2(gg[a][0], gg[a][1]); o.y = pk2(gg[a][2], gg[a][3]); *(u32x2*)(Gb + (size_t)(64 * tt + 4 * tg + a) * RW_W + col0) = o;
            }
        }
#pragma unroll 1
        for (int a = 0; a < 4; ++a) {
            const f32x4 kkv = *(const f32x4*)(k_k + col0), kav = *(const f32x4*)(k_a + col0), rkv = *(const f32x4*)(r_k + col0);
            const f32x4 mur = *(const f32x4*)(mu + col0), muk = *(const f32x4*)(mu + 512 + col0), muv = *(const f32x4*)(mu + 1024 + col0);
            const f32x4 wv4 = *(const LAS f32x4*)(act + (4 * tg + a) * 128 + 4 * cg), av4 = *(const LAS f32x4*)(act + 8192 + (4 * tg + a) * 128 + 4 * cg);
            const int t = 64 * tt + 4 * tg + a; const bool first = (t & (SEQ - 1)) == 0; const int b = t >> 11, s = t & (SEQ - 1);
            const bf16* pr = P + (size_t)t * RW_COLS + col0; const bf16* pp = pr - RW_COLS;
            const u32x2 r2 = *(const u32x2*)pr, k2 = *(const u32x2*)(pr + 512), v2 = *(const u32x2*)(pr + 1024);
            u32x2 rp = {0u, 0u}, kp = {0u, 0u}, vp = {0u, 0u}; if (!first) { rp = *(const u32x2*)pp; kp = *(const u32x2*)(pp + 512); vp = *(const u32x2*)(pp + 1024); }
            const float rc[4] = {bfl(r2.x), bfh(r2.x), bfl(r2.y), bfh(r2.y)}, rq[4] = {bfl(rp.x), bfh(rp.x), bfl(rp.y), bfh(rp.y)};
            const float kc[4] = {bfl(k2.x), bfh(k2.x), bfl(k2.y), bfh(k2.y)}, kq[4] = {bfl(kp.x), bfh(kp.x), bfl(kp.y), bfh(kp.y)};
            const float vc[4] = {bfl(v2.x), bfh(v2.x), bfl(v2.y), bfh(v2.y)}, vq[4] = {bfl(vp.x), bfh(vp.x), bfl(vp.y), bfh(vp.y)};
            float r[4], k[4], v[4], kk[4], om[4], av[4]; float ssq = 0.f;
#pragma unroll
            for (int c = 0; c < 4; ++c) {
                r[c] = rc[c] + mur[c] * (rq[c] - rc[c]); k[c] = kc[c] + muk[c] * (kq[c] - kc[c]); v[c] = vc[c] + muv[c] * (vq[c] - vc[c]);
                const float wv = wv4[c];
                const float wlog = -0.69314718f * __builtin_amdgcn_logf(1.f + __builtin_amdgcn_exp2f(-1.44269504f * wv)) - 0.5f;
                const float e = __builtin_amdgcn_exp2f(1.44269504f * wlog);
                om[c] = 1.f - __builtin_amdgcn_exp2f(-1.44269504f * e);
                av[c] = __builtin_amdgcn_rcpf(1.f + __builtin_amdgcn_exp2f(-1.44269504f * av4[c]));
                kk[c] = k[c] * kkv[c]; ssq += kk[c] * kk[c];
            }
            ssq = row_sum16(ssq);
            const float rn = 1.f / fmaxf(sqrtf(ssq), 1e-12f);
            float kt[4], nbv[4]; float bon = 0.f;
#pragma unroll
            for (int c = 0; c < 4; ++c) { kk[c] *= rn; kt[c] = k[c] * (1.f + (av[c] - 1.f) * kav[c]); nbv[c] = -kk[c] * av[c]; bon += r[c] * kt[c] * rkv[c]; }
            bon = row_sum16(bon);
            if ((cg & 15) == 0) RB[(size_t)t * 8 + h] = bon;
            bf16* sp = SI + ((size_t)(b * RW_H + h) * SEQ + s) * 384 + kidx;
            u32x2 o;
            o.x = pk2(r[0], r[1]); o.y = pk2(r[2], r[3]); *(u32x2*)(sp) = o;
            o.x = pk2(kt[0], kt[1]); o.y = pk2(kt[2], kt[3]); *(u32x2*)(sp + 64) = o;
            o.x = pk2(kk[0], kk[1]); o.y = pk2(kk[2], kk[3]); *(u32x2*)(sp + 128) = o;
            o.x = pk2(nbv[0], nbv[1]); o.y = pk2(nbv[2], nbv[3]); *(u32x2*)(sp + 192) = o;
            o.x = pk2(om[0], om[1]); o.y = pk2(om[2], om[3]); *(u32x2*)(sp + 256) = o;
            o.x = pk2(v[0], v[1]); o.y = pk2(v[2], v[3]); *(u32x2*)(sp + 320) = o;
        }
    }
    __syncthreads();
}
__device__ __forceinline__ void retention_unit(KArgs A, Frame& F, int l, int bh) {
    const int tid = F.tid, lane = F.lane, wave = F.wave;
    const int b = bh >> 2, h = bh & 3;
    LAS bf16* Qs = (LAS bf16*)F.lds; LAS bf16* Ks = (LAS bf16*)(F.lds + 17408); LAS bf16* Vs = (LAS bf16*)(F.lds + 34816);
    LAS float* Ss = (LAS float*)(F.lds + 51200); LAS float* St = (LAS float*)(F.lds + 68608); LAS float* red = (LAS float*)(F.lds + 134144);
    const bf16* P = (const bf16*)(F.ws + WS_PRET); bf16* YY = (bf16*)(F.ws + WS_YR);
    const float* ctab = (const float*)(F.ws + WS_ROPE); const float* stab = ctab + SEQ * 64;
    const float* gng = IN(7) + (size_t)l * RET_W + h * RET_HD;
    const float lg = __builtin_amdgcn_logf(1.f - exp2f(-5.f - (float)h));
    for (int i = tid; i < 128 * 128; i += NWAVES * 64) St[i] = 0.f;
    const float gC = exp2f(lg * 64.f);
    for (int n = 0; n < NCHUNK; ++n) {
        __syncthreads();
        {
            const int c = tid >> 3, p = tid & 7; const int s = n * CHUNK + c; const size_t t = (size_t)b * SEQ + s;
            const bf16* pr = P + t * 2048 + h * RET_HD;
            const v4u q1 = *(const v4u*)(pr + 8 * p), q2 = *(const v4u*)(pr + 64 + 8 * p), k1 = *(const v4u*)(pr + 512 + 8 * p), k2 = *(const v4u*)(pr + 512 + 64 + 8 * p);
            const f32x4 c0 = *(const f32x4*)(ctab + s * 64 + 8 * p), c1 = *(const f32x4*)(ctab + s * 64 + 8 * p + 4), s0 = *(const f32x4*)(stab + s * 64 + 8 * p), s1 = *(const f32x4*)(stab + s * 64 + 8 * p + 4);
            const unsigned qa[4] = {q1.x, q1.y, q1.z, q1.w}, qb[4] = {q2.x, q2.y, q2.z, q2.w}, ka[4] = {k1.x, k1.y, k1.z, k1.w}, kb[4] = {k2.x, k2.y, k2.z, k2.w};
            const float cs[8] = {c0.x, c0.y, c0.z, c0.w, c1.x, c1.y, c1.z, c1.w}, sn[8] = {s0.x, s0.y, s0.z, s0.w, s1.x, s1.y, s1.z, s1.w};
            unsigned o1[4], o2[4], o3[4], o4[4];
#pragma unroll
            for (int z = 0; z < 4; ++z) {
                const float a0 = bfl(qa[z]), a1 = bfh(qa[z]), b0 = bfl(qb[z]), b1 = bfh(qb[z]);
                o1[z] = pk2(a0 * cs[2 * z] - b0 * sn[2 * z], a1 * cs[2 * z + 1] - b1 * sn[2 * z + 1]);
                o2[z] = pk2(a0 * sn[2 * z] + b0 * cs[2 * z], a1 * sn[2 * z + 1] + b1 * cs[2 * z + 1]);
                const float e0 = bfl(ka[z]) * 0.08838834764831845f, e1 = bfh(ka[z]) * 0.08838834764831845f, f0 = bfl(kb[z]) * 0.08838834764831845f, f1 = bfh(kb[z]) * 0.08838834764831845f;
                o3[z] = pk2(e0 * cs[2 * z] - f0 * sn[2 * z], e1 * cs[2 * z + 1] - f1 * sn[2 * z + 1]);
                o4[z] = pk2(e0 * sn[2 * z] + f0 * cs[2 * z], e1 * sn[2 * z + 1] + f1 * cs[2 * z + 1]);
            }
            *(LAS v4u*)(Qs + c * 136 + 8 * p) = (v4u){o1[0], o1[1], o1[2], o1[3]}; *(LAS v4u*)(Qs + c * 136 + 64 + 8 * p) = (v4u){o2[0], o2[1], o2[2], o2[3]};
            *(LAS v4u*)(Ks + c * 136 + 8 * p) = (v4u){o3[0], o3[1], o3[2], o3[3]}; *(LAS v4u*)(Ks + c * 136 + 64 + 8 * p) = (v4u){o4[0], o4[1], o4[2], o4[3]};
            *(LAS v4u*)(Vs + c * 128 + 16 * p) = *(const v4u*)(pr + 1024 + 16 * p); *(LAS v4u*)(Vs + c * 128 + 16 * p + 8) = *(const v4u*)(pr + 1024 + 16 * p + 8);
        }
        __syncthreads();
        {
            const int c = tid & 63, mg = tid >> 6; float sc[8];
#pragma unroll
            for (int i = 0; i < 8; ++i) sc[i] = 0.f;
#pragma unroll 1
            for (int d = 0; d < 128; d += 4) {
                const u32x2 qv = *(const LAS u32x2*)(Qs + c * 136 + d); const float q0 = bfl(qv.x), q1 = bfh(qv.x), q2 = bfl(qv.y), q3 = bfh(qv.y);
#pragma unroll
                for (int i = 0; i < 8; ++i) { const u32x2 kv = *(const LAS u32x2*)(Ks + (8 * mg + i) * 136 + d); sc[i] += q0 * bfl(kv.x) + q1 * bfh(kv.x) + q2 * bfl(kv.y) + q3 * bfh(kv.y); }
            }
#pragma unroll
            for (int i = 0; i < 8; ++i) { const int m = 8 * mg + i; const int dd = c > m ? c - m : m - c; Ss[c * 68 + m] = sc[i] * exp2f(lg * (float)dd); }
        }
        __syncthreads();
        const int e = tid & 127, cgp = tid >> 7;
        float out[16];
        {
            float cr[16];
#pragma unroll
            for (int i = 0; i < 16; ++i) { out[i] = 0.f; cr[i] = 0.f; }
#pragma unroll 1
            for (int m = 0; m < 64; m += 4) {
                const float v0 = bf1(Vs[(m + 0) * 128 + e]), v1 = bf1(Vs[(m + 1) * 128 + e]), v2 = bf1(Vs[(m + 2) * 128 + e]), v3 = bf1(Vs[(m + 3) * 128 + e]);
#pragma unroll
                for (int i = 0; i < 16; ++i) { const f32x4 s4 = *(const LAS f32x4*)(Ss + (16 * cgp + i) * 68 + m); out[i] += s4.x * v0 + s4.y * v1 + s4.z * v2 + s4.w * v3; }
            }
#pragma unroll 1
            for (int d = 0; d < 128; d += 4) {
                const float t0 = St[(d + 0) * 128 + e], t1 = St[(d + 1) * 128 + e], t2 = St[(d + 2) * 128 + e], t3 = St[(d + 3) * 128 + e];
#pragma unroll
                for (int i = 0; i < 16; ++i) { const u32x2 qv = *(const LAS u32x2*)(Qs + (16 * cgp + i) * 136 + d); cr[i] += bfl(qv.x) * t0 + bfh(qv.x) * t1 + bfl(qv.y) * t2 + bfh(qv.y) * t3; }
            }
#pragma unroll
            for (int i = 0; i < 16; ++i) out[i] += exp2f(lg * (float)(16 * cgp + i + 1)) * cr[i];
        }
        {
#pragma unroll
            for (int i = 0; i < 16; ++i) { const float s1 = wave_sum(out[i]), s2 = wave_sum(out[i] * out[i]); if (lane == 0) { red[wave * 32 + i] = s1; red[wave * 32 + 16 + i] = s2; } }
        }
        __syncthreads();
        {
            const int dg = tid >> 7; float st[32];
#pragma unroll
            for (int j = 0; j < 32; ++j) st[j] = St[(32 * dg + j) * 128 + e] * gC;
#pragma unroll 1
            for (int c = 0; c < 64; ++c) {
                const float v = bf1(Vs[c * 128 + e]) * exp2f(lg * (float)(63 - c));
#pragma unroll
                for (int j = 0; j < 32; j += 4) { const u32x2 kv = *(const LAS u32x2*)(Ks + c * 136 + 32 * dg + j); st[j] += bfl(kv.x) * v; st[j + 1] += bfh(kv.x) * v; st[j + 2] += bfl(kv.y) * v; st[j + 3] += bfh(kv.y) * v; }
            }
#pragma unroll
            for (int j = 0; j < 32; ++j) St[(32 * dg + j) * 128 + e] = st[j];
        }
        {
            const float gw = gng[e];
#pragma unroll
            for (int i = 0; i < 16; ++i) {
                const float s1 = red[wave * 32 + i] + red[(wave ^ 1) * 32 + i], s2 = red[wave * 32 + 16 + i] + red[(wave ^ 1) * 32 + 16 + i];
                const float mean = s1 * (1.f / 128.f), var = fmaxf(s2 * (1.f / 128.f) - mean * mean, 0.f), rstd = 1.f / sqrtf(var + LN_EPS);
                const size_t t = (size_t)b * SEQ + n * CHUNK + 16 * cgp + i;
                const float g = bf1(P[t * 2048 + 1536 + h * RET_HD + e]);
                const float y = (out[i] - mean) * rstd * gw * (g * sigm(g));
                YY[t * RET_W + h * RET_HD + e] = (bf16)f2bf(y);
            }
        }
    }
    __syncthreads();
}

__device__ __forceinline__ void rwkv_scan(Frame& F) {
    if (F.wave >= 4) return;
    const int lane = F.lane, W = F.vcu * 4 + F.wave, bh = W >> 4, rg = W & 15, j = lane & 15, row = 4 * rg + (lane >> 4);
    const bf16* sp = (const bf16*)(F.ws + WS_SI) + (size_t)bh * SEQ * 384;
    float* yraw = (float*)(F.ws + WS_YRAW) + (size_t)(bh >> 3) * SEQ * RW_W + (bh & 7) * RW_HD + row;
    float s0 = 0.f, s1 = 0.f, s2 = 0.f, s3 = 0.f;
    u32x2 cr[4], ck[4], ckk[4], cnb[4], com[4]; bf16 cv[4];
    u32x2 nr[4], nk[4], nkk[4], nnb[4], nom[4]; bf16 nv[4];
#define SCAN_LOAD(R, K, KK, NB, OM, V, t0) do { _Pragma("unroll") for (int u = 0; u < 4; ++u) { const bf16* p = sp + (size_t)((t0) + u) * 384; \
        R[u] = *(const u32x2*)(p + 4 * j); K[u] = *(const u32x2*)(p + 64 + 4 * j); KK[u] = *(const u32x2*)(p + 128 + 4 * j); NB[u] = *(const u32x2*)(p + 192 + 4 * j); OM[u] = *(const u32x2*)(p + 256 + 4 * j); V[u] = p[320 + row]; } } while (0)
    SCAN_LOAD(cr, ck, ckk, cnb, com, cv, 0);
    for (int tb = 0; tb < SEQ; tb += 4) {
        const int tn = (tb + 4 < SEQ) ? tb + 4 : tb;
        SCAN_LOAD(nr, nk, nkk, nnb, nom, nv, tn);
#pragma unroll
        for (int u = 0; u < 4; ++u) {
            const float vv = bf1(cv[u]);
            float dot = s0 * bfl(ckk[u].x) + s1 * bfh(ckk[u].x) + s2 * bfl(ckk[u].y) + s3 * bfh(ckk[u].y);
            dot = row_sum16(dot);
            s0 = s0 * (1.f - bfl(com[u].x)) + dot * bfl(cnb[u].x) + vv * bfl(ck[u].x);
            s1 = s1 * (1.f - bfh(com[u].x)) + dot * bfh(cnb[u].x) + vv * bfh(ck[u].x);
            s2 = s2 * (1.f - bfl(com[u].y)) + dot * bfl(cnb[u].y) + vv * bfl(ck[u].y);
            s3 = s3 * (1.f - bfh(com[u].y)) + dot * bfh(cnb[u].y) + vv * bfh(ck[u].y);
            float y = s0 * bfl(cr[u].x) + s1 * bfh(cr[u].x) + s2 * bfl(cr[u].y) + s3 * bfh(cr[u].y);
            y = row_sum16(y);
            if (j == 0) yraw[(size_t)(tb + u) * RW_W] = y;
        }
#pragma unroll
        for (int u = 0; u < 4; ++u) { cr[u] = nr[u]; ck[u] = nk[u]; ckk[u] = nkk[u]; cnb[u] = nnb[u]; com[u] = nom[u]; cv[u] = nv[u]; }
    }
#undef SCAN_LOAD
}
__device__ __forceinline__ void rwkv_finish(KArgs A, Frame& F, int l) {
    const int gw = F.vcu * NWAVES + F.wave, NGW = F.G * NWAVES, lane = F.lane, h = lane >> 3, c0 = 8 * lane;
    const float* yraw = (const float*)(F.ws + WS_YRAW); const bf16* SI = (const bf16*)(F.ws + WS_SI); const bf16* Gb = (const bf16*)(F.ws + WS_G); const float* RB = (const float*)(F.ws + WS_RB);
    bf16* YY = (bf16*)(F.ws + WS_YK);
    const float* lng = IN(17) + (size_t)l * RW_W + c0; const float* lnb = IN(18) + (size_t)l * RW_W + c0;
    const f32x4 g0 = *(const f32x4*)lng, g1 = *(const f32x4*)(lng + 4), b0 = *(const f32x4*)lnb, b1 = *(const f32x4*)(lnb + 4);
    const float gv[8] = {g0.x, g0.y, g0.z, g0.w, g1.x, g1.y, g1.z, g1.w}, bv[8] = {b0.x, b0.y, b0.z, b0.w, b1.x, b1.y, b1.z, b1.w};
    for (int t = gw; t < T; t += NGW) {
        const f32x4 y0 = *(const f32x4*)(yraw + (size_t)t * RW_W + c0), y1 = *(const f32x4*)(yraw + (size_t)t * RW_W + c0 + 4);
        float y[8] = {y0.x, y0.y, y0.z, y0.w, y1.x, y1.y, y1.z, y1.w};
        float s = 0.f;
#pragma unroll
        for (int i = 0; i < 8; ++i) s += y[i];
        const float mean = row_sum8(s) * (1.f / 64.f); float q = 0.f;
#pragma unroll
        for (int i = 0; i < 8; ++i) { y[i] -= mean; q += y[i] * y[i]; }
        const float rstd = 1.f / sqrtf(row_sum8(q) * (1.f / 64.f) + RW_GN_EPS);
        const int b = t >> 11, sq = t & (SEQ - 1);
        const v4u vv = *(const v4u*)(SI + ((size_t)(b * RW_H + h) * SEQ + sq) * 384 + 320 + (c0 & 63));
        const v4u gg = *(const v4u*)(Gb + (size_t)t * RW_W + c0);
        const float bon = RB[(size_t)t * 8 + h];
        const unsigned vw[4] = {vv.x, vv.y, vv.z, vv.w}, gwv[4] = {gg.x, gg.y, gg.z, gg.w}; unsigned o[4];
#pragma unroll
        for (int i = 0; i < 4; ++i) {
            const float a0 = (y[2 * i] * rstd * gv[2 * i] + bv[2 * i] + bon * bfl(vw[i])) * bfl(gwv[i]);
            const float a1 = (y[2 * i + 1] * rstd * gv[2 * i + 1] + bv[2 * i + 1] + bon * bfh(vw[i])) * bfh(gwv[i]);
            o[i] = pk2(a0, a1);
        }
        *(v4u*)(YY + (size_t)t * RW_W + c0) = (v4u){o[0], o[1], o[2], o[3]};
    }
}
template <bool ROUTE> __device__ __forceinline__ void ln_phase(KArgs A, Frame& F, int l, const float* g, const float* b) {
    const int gw = F.vcu * NWAVES + F.wave, NGW = F.G * NWAVES, lane = F.lane;
    const float* H1 = (const float*)(F.ws + WS_H1); bf16* XN = (bf16*)(F.ws + WS_XN);
    const float* rw = IN(4); const float* rbias = IN(5);
    int* lists = (int*)(F.ws + WS_LISTS); int* tokinfo = (int*)(F.ws + WS_TOKINFO);
    for (int m = gw; m < T; m += NGW) {
        float* xr = F.X + (size_t)m * D; const float* hr = H1 + (size_t)m * D; f32x4 v[4];
#pragma unroll
        for (int j = 0; j < 4; ++j) v[j] = *(const f32x4*)(xr + 4 * lane + 256 * j) * ALPHA + *(const f32x4*)(hr + 4 * lane + 256 * j);
        ln_store(v, g, b, xr, XN + (size_t)m * D, lane);
        if (ROUTE) {
            float lg[16];
#pragma unroll
            for (int e = 0; e < 16; ++e) lg[e] = 0.f;
#pragma unroll
            for (int j = 0; j < 4; ++j)
#pragma unroll
                for (int q = 0; q < 4; ++q) { const float xv = v[j][q]; const float* wr_ = rw + (size_t)(4 * lane + 256 * j + q) * NE;
                    const f32x4 w0 = *(const f32x4*)wr_, w1 = *(const f32x4*)(wr_ + 4), w2 = *(const f32x4*)(wr_ + 8), w3 = *(const f32x4*)(wr_ + 12);
                    lg[0] += xv * w0.x; lg[1] += xv * w0.y; lg[2] += xv * w0.z; lg[3] += xv * w0.w; lg[4] += xv * w1.x; lg[5] += xv * w1.y; lg[6] += xv * w1.z; lg[7] += xv * w1.w;
                    lg[8] += xv * w2.x; lg[9] += xv * w2.y; lg[10] += xv * w2.z; lg[11] += xv * w2.w; lg[12] += xv * w3.x; lg[13] += xv * w3.y; lg[14] += xv * w3.z; lg[15] += xv * w3.w; }
            float aff[16], ch[16];
#pragma unroll
            for (int e = 0; e < 16; ++e) { lg[e] = wave_sum(lg[e]); aff[e] = 1.f / (1.f + expf(-lg[e])); ch[e] = aff[e] + rbias[e]; }
            float gs[4];
#pragma unroll
            for (int q = 0; q < 4; ++q) { const float a = ch[4 * q], bb = ch[4 * q + 1], c = ch[4 * q + 2], d = ch[4 * q + 3];
                const float hi1 = fmaxf(a, bb), lo1 = fminf(a, bb), hi2 = fmaxf(c, d), lo2 = fminf(c, d);
                gs[q] = fmaxf(hi1, hi2) + fmaxf(fminf(hi1, hi2), fmaxf(lo1, lo2)); }
            int bg = 0; float best = gs[0];
#pragma unroll
            for (int q = 1; q < 4; ++q) if (gs[q] > best) { best = gs[q]; bg = q; }
            float c4[4], a4[4];
#pragma unroll
            for (int i = 0; i < 4; ++i) { c4[i] = bg == 0 ? ch[i] : bg == 1 ? ch[4 + i] : bg == 2 ? ch[8 + i] : ch[12 + i]; a4[i] = bg == 0 ? aff[i] : bg == 1 ? aff[4 + i] : bg == 2 ? aff[8 + i] : aff[12 + i]; }
            int i1 = 0; float m1 = c4[0];
#pragma unroll
            for (int i = 1; i < 4; ++i) if (c4[i] > m1) { m1 = c4[i]; i1 = i; }
            int i2 = -1; float m2 = 0.f;
#pragma unroll
            for (int i = 0; i < 4; ++i) if (i != i1 && (i2 < 0 || c4[i] > m2)) { m2 = c4[i]; i2 = i; }
            const float af1 = i1 == 0 ? a4[0] : i1 == 1 ? a4[1] : i1 == 2 ? a4[2] : a4[3], af2 = i2 == 0 ? a4[0] : i2 == 1 ? a4[1] : i2 == 2 ? a4[2] : a4[3];
            const float inv = 1.f / (af1 + af2);
            if (lane == 0) {
                const int e1 = 4 * bg + i1, e2 = 4 * bg + i2;
                const int p1 = (int)__hip_atomic_fetch_add(F.ctl + CW_CNT + l * 1024 + 64 * e1, 1u, RLX_AGENT);
                const int p2 = (int)__hip_atomic_fetch_add(F.ctl + CW_CNT + l * 1024 + 64 * e2, 1u, RLX_AGENT);
                lists[e1 * T + p1] = m; lists[e2 * T + p2] = m;
                int* ti = tokinfo + (size_t)m * 8;
                ti[0] = e1; ti[1] = p1; ti[2] = __float_as_int(af1 * inv); ti[3] = e2; ti[4] = p2; ti[5] = __float_as_int(af2 * inv);
            }
        }
    }
}
__device__ __forceinline__ void moe_prefix(Frame& F, int l) {
    if (F.tid == 0) { int acc = 0;
        for (int e = 0; e < NE; ++e) { F.MISC[32 + e] = (unsigned)acc; const unsigned c = __hip_atomic_load(F.ctl + CW_CNT + l * 1024 + 64 * e, RLX_AGENT); acc += (int)((c + 255u) >> 8); }
        F.MISC[32 + NE] = (unsigned)acc; }
    __syncthreads();
}
__device__ __forceinline__ void moe_gather(Frame& F, int l) {
    moe_prefix(F, l);
    const int gw = F.vcu * NWAVES + F.wave, NGW = F.G * NWAVES, lane = F.lane;
    const int* lists = (const int*)(F.ws + WS_LISTS); const bf16* XN = (const bf16*)(F.ws + WS_XN); bf16* XG = (bf16*)(F.ws + WS_XG);
    const int nrows = (int)F.MISC[32 + NE] * 256;
    for (int R = gw; R < nrows; R += NGW) {
        const int mt = R >> 8; int e = 0;
#pragma unroll
        for (int q = 1; q < 16; ++q) e += (mt >= (int)F.MISC[32 + q]) ? 1 : 0;
        const int pos = R - (int)F.MISC[32 + e] * 256; const int cnt = (int)__hip_atomic_load(F.ctl + CW_CNT + l * 1024 + 64 * e, RLX_AGENT);
        v4u a = {0u, 0u, 0u, 0u}, b = {0u, 0u, 0u, 0u};
        if (pos < cnt) { const int tok = lists[e * T + pos]; const v4u* src = (const v4u*)(XN + (size_t)tok * D); a = src[lane]; b = src[64 + lane]; }
        v4u* dst = (v4u*)(XG + (size_t)R * D); dst[lane] = a; dst[64 + lane] = b;
    }
}
__device__ __forceinline__ void moe_combine_ln(Frame& F, int l, const float* g, const float* b) {
    moe_prefix(F, l);
    const int gw = F.vcu * NWAVES + F.wave, NGW = F.G * NWAVES, lane = F.lane;
    const int* tokinfo = (const int*)(F.ws + WS_TOKINFO); const bf16* YM = (const bf16*)(F.ws + WS_YM); bf16* XN = (bf16*)(F.ws + WS_XN);
    for (int m = gw; m < T; m += NGW) {
        const int* ti = tokinfo + (size_t)m * 8;
        const int e1 = ti[0], p1 = ti[1], e2 = ti[3], p2 = ti[4]; const float w1 = __int_as_float(ti[2]), w2 = __int_as_float(ti[5]);
        const bf16* y1 = YM + ((size_t)F.MISC[32 + e1] * 256 + p1) * D; const bf16* y2 = YM + ((size_t)F.MISC[32 + e2] * 256 + p2) * D;
        float* xr = F.X + (size_t)m * D; f32x4 v[4];
#pragma unroll
        for (int j = 0; j < 4; ++j) { const u32x2 a = *(const u32x2*)(y1 + 4 * lane + 256 * j), c = *(const u32x2*)(y2 + 4 * lane + 256 * j);
            const f32x4 ya = {bfl(a.x), bfh(a.x), bfl(a.y), bfh(a.y)}, yc = {bfl(c.x), bfh(c.x), bfl(c.y), bfh(c.y)};
            v[j] = *(const f32x4*)(xr + 4 * lane + 256 * j) * ALPHA + ya * w1 + yc * w2; }
        ln_store(v, g, b, xr, XN + (size_t)m * D, lane);
    }
}

__device__ __forceinline__ void attn_phase(Frame& F) {
    typedef float f32x16 __attribute__((ext_vector_type(16))); typedef short s16x4 __attribute__((ext_vector_type(4)));
    const int u = F.vcu, b = u >> 5, h = (u >> 3) & 3, qb = u & 7, lane = F.lane, r = lane & 31, hh = lane >> 5;
    if (u >= BATCH * XA_H * 8) return;
    const size_t q0 = (size_t)b * SEQ + qb * 256 + F.wave * 32;
    const bf16* Qp = (const bf16*)(F.ws + WS_Q) + (q0 + r) * D + h * XA_HD + 8 * hh;
    const bf16* Kp = (const bf16*)(F.ws + WS_MK) + ((size_t)b * MEM_LEN + r) * D + h * XA_HD + 8 * hh;
    const bf16* Vp = (const bf16*)(F.ws + WS_VT) + ((size_t)h * XA_HD + r) * MEMT + b * MEM_LEN + 4 * hh;
    bf16* Op = (bf16*)(F.ws + WS_O) + q0 * D + h * XA_HD + r;
    f32x16 acc[8];
#pragma unroll
    for (int kb = 0; kb < 8; ++kb) {
        f32x16 a = {0.f, 0.f, 0.f, 0.f, 0.f, 0.f, 0.f, 0.f, 0.f, 0.f, 0.f, 0.f, 0.f, 0.f, 0.f, 0.f};
#pragma unroll 4
        for (int s = 0; s < 16; ++s) { const bf16x8 kf = *(const bf16x8*)(Kp + (size_t)kb * 32 * D + 16 * s), qf = *(const bf16x8*)(Qp + 16 * s); a = __builtin_amdgcn_mfma_f32_32x32x16_bf16(kf, qf, a, 0, 0, 0); }
        acc[kb] = a;
    }
    float mx = -INFINITY;
#pragma unroll
    for (int kb = 0; kb < 8; ++kb)
#pragma unroll
        for (int i = 0; i < 16; ++i) mx = fmaxf(mx, acc[kb][i]);
    mx = fmaxf(mx, __shfl_xor(mx, 32));
    float sum = 0.f;
#pragma unroll
    for (int kb = 0; kb < 8; ++kb)
#pragma unroll
        for (int i = 0; i < 16; ++i) { const float p = __builtin_amdgcn_exp2f(acc[kb][i] - mx); acc[kb][i] = p; sum += p; }
    sum += __shfl_xor(sum, 32);
    const float inv = 1.f / sum;
    bf16x8 pf[16];
#pragma unroll
    for (int s = 0; s < 16; ++s) { const int kb = s >> 1, o = 8 * (s & 1); v4u w;
        w.x = pk2(acc[kb][o + 0] * inv, acc[kb][o + 1] * inv); w.y = pk2(acc[kb][o + 2] * inv, acc[kb][o + 3] * inv); w.z = pk2(acc[kb][o + 4] * inv, acc[kb][o + 5] * inv); w.w = pk2(acc[kb][o + 6] * inv, acc[kb][o + 7] * inv);
        pf[s] = __builtin_bit_cast(bf16x8, w); }
#pragma unroll 1
    for (int db = 0; db < 8; ++db) {
        f32x16 o = {0.f, 0.f, 0.f, 0.f, 0.f, 0.f, 0.f, 0.f, 0.f, 0.f, 0.f, 0.f, 0.f, 0.f, 0.f, 0.f};
        const bf16* vp = Vp + (size_t)db * 32 * MEMT;
#pragma unroll
        for (int s = 0; s < 16; ++s) { const s16x4 lo = *(const s16x4*)(vp + 16 * s), hi = *(const s16x4*)(vp + 16 * s + 8);
            const bf16x8 vf = {lo[0], lo[1], lo[2], lo[3], hi[0], hi[1], hi[2], hi[3]};
            o = __builtin_amdgcn_mfma_f32_32x32x16_bf16(pf[s], vf, o, 0, 0, 0); }
#pragma unroll
        for (int i = 0; i < 16; ++i) { const int qr = (i & 3) + 8 * (i >> 2) + 4 * hh; Op[(size_t)qr * D + db * 32] = (bf16)f2bf(o[i]); }
    }
}
#ifndef PHMASK
#define PHMASK 0xFFFFFFFFu
#endif
#define PHON(i) ((PHMASK >> (i)) & 1u)
__global__ void __launch_bounds__(NWAVES * 64, 2) skel_fwd(Args args) {
    extern __shared__ __attribute__((aligned(16))) unsigned char lds[];
    Frame F;
    F.lds = (LAS unsigned char*)lds; F.MISC = (volatile LAS unsigned*)(F.lds + MISC_OFF);
    F.tid = threadIdx.x; F.lane = F.tid & 63; F.wave = __builtin_amdgcn_readfirstlane(F.tid >> 6);
    F.G = gridDim.x; { const int bx = blockIdx.x; F.vcu = (F.G % 8 == 0) ? (bx % 8) * (F.G / 8) + bx / 8 : bx; }
    F.X = args.out; F.ws = args.ws; F.ctl = (gu32*)(args.ws + WS_CTL);
    for (int u = F.tid; u < 128; u += NWAVES * 64) ((LAS unsigned*)(F.lds + MISC_OFF))[u] = 0u;
    __syncthreads();
    XcdBarrier bar; bar.bar = (unsigned*)(F.ctl + CW_BAR); bar.x = 0; bar.st = nullptr;
    const bool multi = (args.ph_hi - args.ph_lo) > 1;
    if (multi) bar = xcd_barrier_post((unsigned*)(F.ctl + CW_BAR), F.MISC + 8);
    unsigned char* ws = args.ws;
    LAS unsigned char* ring = F.lds;
    typedef pg8::bf16_t bt; typedef const pg8::bf16_t cbt;
    for (int ph = args.ph_lo; ph < args.ph_hi; ++ph) {
        const int l = ph == 0 ? 0 : (ph - 1) / 15, k = ph == 0 ? -1 : (ph - 1) % 15;
        int c = (int)blockIdx.x; asm volatile("" : "+s"(c));
        F.vcu = (F.G % 8 == 0) ? (c % 8) * (F.G / 8) + c / 8 : c;
        { int t_ = threadIdx.x; asm volatile("" : "+v"(t_)); F.tid = t_; F.lane = t_ & 63; F.wave = __builtin_amdgcn_readfirstlane(t_ >> 6); }
        KArgs A = (KArgs)__builtin_amdgcn_kernarg_segment_ptr(); asm volatile("" : "+s"(A));
        ws = A->ws; F.ws = ws; F.X = A->out; F.ctl = (gu32*)(ws + WS_CTL);
        switch (k) {
        case -1: if (PHON(0)) p0_prologue(A, F); break;
        case 1: if (PHON(2)) { if (F.vcu < BATCH * RET_H) retention_unit(A, F, l, F.vcu); else rwkv_prep(A, F, l, F.vcu - BATCH * RET_H, F.G - BATCH * RET_H); } break;
        case 2: if (PHON(3)) rwkv_scan(F); break;
        case 6: if (PHON(7)) { ln_phase<false>(A, F, l, IN(22) + (size_t)l * D, IN(23) + (size_t)l * D); convert_wm(A, F, l); } break;
        case 8: if (PHON(9)) attn_phase(F); break;
        case 10: if (PHON(10)) ln_phase<true>(A, F, l, IN(27) + (size_t)l * D, IN(28) + (size_t)l * D); break;
        case 11: if (PHON(11)) moe_gather(F, l); break;
        case 12: case 13: if (PHON(12)) moe_prefix(F, l); break;
        case 14: if (PHON(14)) { moe_combine_ln(F, l, IN(32) + (size_t)l * D, IN(33) + (size_t)l * D); if (l + 1 < DEPTH) convert_wa(A, F, l + 1); } break;
        default: break;
        }
        const int njobs = (k == 0) ? 3 : (k == 4) ? 2 : (k == 3 || k == 5 || k == 7 || k == 9 || k == 12 || k == 13) ? 1 : 0;
        if (PHON(1))
        for (int j = 0; j < njobs; ++j) {
            pg8::Gemm g{nullptr, nullptr, 0, 0, D}; int M = T, N = D, moe = 0;
            pg8::EpiU E{pg8::EM_BF16, nullptr, D, 0xffff, nullptr, 0, 0xffff, 0, 1.f, nullptr, nullptr};
            if (k == 0) {
                if (j == 0) { g.A = (cbt*)(ws + WS_XN); g.Bt = (cbt*)(ws + WS_WIN); N = N1; E.O0 = (bt*)(ws + WS_PRET); E.ld0 = 2048; E.npn0 = 8; E.O1 = (bt*)(ws + WS_PRW); E.ld1 = RW_COLS; }
                else if (j == 1) { g.A = (cbt*)(ws + WS_MEMB); g.Bt = (cbt*)(ws + WS_WKV); M = MEMT; E.O0 = (bt*)(ws + WS_MK); }
                else { g.A = (cbt*)(ws + WS_WKV) + (size_t)D * D; g.Bt = (cbt*)(ws + WS_MEMB); M = D; N = MEMT; E.O0 = (bt*)(ws + WS_VT); E.ld0 = MEMT; }
            } else if (k == 3) { g.A = (cbt*)(ws + WS_XN); g.Bt = (cbt*)(ws + WS_WIN) + (size_t)N1 * D; N = NGATE; E.O0 = (bt*)(ws + WS_PGATE); E.ld0 = NGATE; E.act = 1; }
            else if (k == 4) { g.K = RET_W; E.G = (cbt*)(ws + WS_PGATE); E.F = (float*)(ws + WS_M1); E.O0 = (bt*)(ws + WS_MRG);
                if (j == 0) { g.A = (cbt*)(ws + WS_YR); g.Bt = (cbt*)(ws + WS_WRU); E.mode = pg8::EM_MERGE0; } else { g.A = (cbt*)(ws + WS_YK); g.Bt = (cbt*)(ws + WS_WKU); E.mode = pg8::EM_MERGE1; } }
            else if (k == 5) { g.A = (cbt*)(ws + WS_MRG); g.Bt = (cbt*)(ws + WS_WOUT); E.mode = pg8::EM_F32; E.F = (float*)(ws + WS_H1); }
            else if (k == 7) { g.A = (cbt*)(ws + WS_XN); g.Bt = (cbt*)(ws + WS_WQ); E.O0 = (bt*)(ws + WS_Q); E.scale = 0.0625f * 1.44269504f; }
            else if (k == 9) { g.A = (cbt*)(ws + WS_O); g.Bt = (cbt*)(ws + WS_WO); E.mode = pg8::EM_F32; E.F = (float*)(ws + WS_H1); }
            else if (k == 12) { g.A = (cbt*)(ws + WS_XG); g.Bt = (cbt*)(ws + WS_WMA); moe = 1; E.mode = pg8::EM_MOEA; E.O0 = (bt*)(ws + WS_HM); }
            else { g.A = (cbt*)(ws + WS_HM); g.Bt = (cbt*)(ws + WS_WMB); g.K = DE; moe = 1; E.O0 = (bt*)(ws + WS_YM); E.pn_mask = 3; }
            pg8::OrderU S; S.st.init(M, N, F.G, c); S.moe = moe; S.tp = (const LAS int*)(F.lds + MISC_OFF + 128);
            pg8::gemm_phase<pg8::EpiU, pg8::OrderU, true, true>(ring, g, S, E);
        }
        if (k == 3 && PHON(4)) rwkv_finish(A, F, l);
        if (ph + 1 < args.ph_hi) xcd_barrier(bar);
    }
}

extern "C" void kernel_launch(void* const* d_in, const int* in_sizes, int n_in, void* d_out, int out_size, void* d_ws, size_t ws_size, hipStream_t stream) {
    static int grid = 0;
    if (grid == 0) {
        if (n_in != 34 || in_sizes[0] != T * D || out_size != T * D || ws_size < WS_END) { fprintf(stderr, "kernel_launch: unexpected problem shape (n_in %d, in0 %d, out %d, ws %zu, need %zu)\n", n_in, n_in > 0 ? in_sizes[0] : -1, out_size, ws_size, (size_t)WS_END); grid = -1; return; }
        int dev = 0, cus = 0;
        if (hipGetDevice(&dev) != hipSuccess || hipDeviceGetAttribute(&cus, hipDeviceAttributeMultiprocessorCount, dev) != hipSuccess) { grid = -1; return; }
        if (hipFuncSetAttribute((const void*)skel_fwd, hipFuncAttributeMaxDynamicSharedMemorySize, LDS_BYTES) != hipSuccess) { fprintf(stderr, "kernel_launch: hipFuncSetAttribute failed\n"); grid = -1; return; }
        int per_cu = 0;
        if (hipOccupancyMaxActiveBlocksPerMultiprocessor(&per_cu, (const void*)skel_fwd, NWAVES * 64, LDS_BYTES) != hipSuccess || per_cu < 1) fprintf(stderr, "kernel_launch: occupancy query reports %d\n", per_cu);
        (void)hipGetLastError();
        grid = cus;
        if (grid != 256) fprintf(stderr, "kernel_launch: %d CUs (built for 256)\n", grid);
    }
    if (grid < 0) return;
    (void)hipMemsetAsync((char*)d_ws + WS_CTL, 0, CTL_ZERO_BYTES, stream);
    Args a{};
    for (int i = 0; i < 34; ++i) a.in[i] = (const float*)d_in[i];
    a.out = (float*)d_out; a.ws = (unsigned char*)d_ws;
#if MK_ONE_LAUNCH
    a.ph_lo = 0; a.ph_hi = N_PHASES;
    hipLaunchKernelGGL(skel_fwd, dim3(grid), dim3(NWAVES * 64), LDS_BYTES, stream, a);
#else
    for (int ph = 0; ph < N_PHASES; ++ph) { a.ph_lo = ph; a.ph_hi = ph + 1; hipLaunchKernelGGL(skel_fwd, dim3(grid), dim3(NWAVES * 64), LDS_BYTES, stream, a); }
#endif
}
```

```cpp
#include <hip/hip_runtime.h>
#include <cstdio>
#include <cstdint>
namespace pg8 {
#define PG8_LAS __attribute__((address_space(3)))
typedef unsigned short bf16_t;
typedef short bf16x8 __attribute__((ext_vector_type(8)));
typedef float f32x4 __attribute__((ext_vector_type(4)));
typedef unsigned u32x4 __attribute__((ext_vector_type(4)));
constexpr int BM = 256, BK = 64, HALF = 128, HTB = HALF * BK * 2  , STAGE_BYTES = 8 * HTB, NXCD = 8, WGM = 8;

__host__ __device__ __forceinline__ int lds_byte(int r, int c) { const int st = (r >> 4) * 2 + (c >> 5), rr = r & 15, cc = c & 31, ob = rr * 64 + cc * 2; return st * 1024 + (ob ^ (((ob >> 9) & 1) << 5)); }
__host__ __device__ __forceinline__ void stage_rc(int b, int& R, int& C) { const int st = b / 1024, sb = b % 1024, swz = sb ^ (((sb >> 9) & 1) << 5); R = (st >> 1) * 16 + swz / 64; C = (st & 1) * 32 + (swz % 64) / 2; }
__host__ __device__ __forceinline__ int perm32(int rho) { const int n = rho >> 4, i = rho & 15; return 8 * (i >> 2) + 4 * n + (i & 3); }

struct Unit { int pm, pn; };
struct Gemm { const bf16_t* A; const bf16_t* Bt; int M, N, K; };

struct StaticOrder {
    int nM, nN, nwg, G, c;
    __host__ __device__ void init(int M, int N, int G_, int c_) { nM = M / BM; nN = N / BM; nwg = nM * nN; G = G_; c = c_; }
    __host__ __device__ bool next(int i, Unit& u) const {
        const long L = (long)i * G + c; if (L >= nwg) return false;
        int wgid = (int)L; { const int q = nwg / NXCD, r = nwg % NXCD, xcd = wgid % NXCD, off = wgid / NXCD; wgid = (xcd < r ? xcd * (q + 1) : r * (q + 1) + (xcd - r) * q) + off; }
        const int nig = WGM * nN, gid = wgid / nig, fm = gid * WGM, gsz = (nM - fm) < WGM ? (nM - fm) : WGM;
        u.pm = fm + ((wgid % nig) % gsz); u.pn = (wgid % nig) / gsz; return true;
    }
    __device__ __forceinline__ void a_ready(const Unit&) const {}
    __device__ __forceinline__ void done(const Unit&) const {}
};

__device__ __forceinline__ unsigned cvt_pk_bf16(float lo, float hi) { unsigned r; asm volatile("v_cvt_pk_bf16_f32 %0, %1, %2" : "=v"(r) : "v"(lo), "v"(hi)); return r; }
typedef float f32x2 __attribute__((ext_vector_type(2)));
__device__ __forceinline__ f32x2 gelu_pk(f32x2 v) {
    const f32x2 av = __builtin_elementwise_abs(v), d = av * 0.2316418882f + 1.0f;
    f32x2 t; t.x = __builtin_amdgcn_rcpf(d.x); t.y = __builtin_amdgcn_rcpf(d.y);
    f32x2 q = t * 0.5307027145f + (-0.7265760135f); q = q * t + 0.7107068705f; q = q * t + (-0.142248368f); q = q * t + 0.127414796f; q = q * t;
    const f32x2 s = (v * v) * (-0.72134752044f);
    f32x2 e; e.x = __builtin_amdgcn_exp2f(s.x); e.y = __builtin_amdgcn_exp2f(s.y);
    const f32x2 m = v * (q * e), r = v - m;
    f32x2 o; o.x = v.x < 0.f ? m.x : r.x; o.y = v.y < 0.f ? m.y : r.y; return o;
}

template <int ACT  > struct EpiBf16 {
    static constexpr bool PERM = true, AFTER_DRAIN = false; static_assert(ACT == 0 || ACT == 1, "EpiBf16: ACT is 0 (none) or 1 (gelu_pk)");
    bf16_t* O; int ldc; const float* bias; int split_cols; size_t split_stride; float scale0;
    __device__ __forceinline__ void operator()(const f32x4 (&acc)[2][2][4][2], const Unit& u, int wr, int wc, int fr, int fq) const {
        const int row0 = u.pm * BM + wr * 64 + fr; int colt = u.pn * BM; bf16_t* base = O;
        float sc = 1.f; if (split_cols) { const int t = colt / split_cols; base += (size_t)t * split_stride; colt -= t * split_cols; if (t == 0) sc = scale0; }
        const int col0 = colt + wc * 32 + 8 * fq, bcol0 = u.pn * BM + wc * 32 + 8 * fq;
        f32x4 bv[2][2];
#pragma unroll
        for (int bj = 0; bj < 2; ++bj)
#pragma unroll
            for (int n = 0; n < 2; ++n) bv[bj][n] = bias ? *(const f32x4*)(bias + bcol0 + bj * HALF + 4 * n) : (f32x4){0.f, 0.f, 0.f, 0.f};
#pragma unroll
        for (int ai = 0; ai < 2; ++ai)
#pragma unroll
            for (int m = 0; m < 4; ++m) { bf16_t* rowp = base + (size_t)(row0 + ai * HALF + m * 16) * ldc + col0;
#pragma unroll
                for (int bj = 0; bj < 2; ++bj) { f32x4 v0 = acc[ai][bj][m][0] + bv[bj][0], v1 = acc[ai][bj][m][1] + bv[bj][1];
                    if (ACT == 1) { f32x2 a = gelu_pk((f32x2){v0[0], v0[1]}), b = gelu_pk((f32x2){v0[2], v0[3]}), c = gelu_pk((f32x2){v1[0], v1[1]}), d = gelu_pk((f32x2){v1[2], v1[3]});
                        v0 = (f32x4){a.x, a.y, b.x, b.y}; v1 = (f32x4){c.x, c.y, d.x, d.y}; }
                    v0 = v0 * sc; v1 = v1 * sc; u32x4 w; w.x = cvt_pk_bf16(v0[0], v0[1]); w.y = cvt_pk_bf16(v0[2], v0[3]); w.z = cvt_pk_bf16(v1[0], v1[1]); w.w = cvt_pk_bf16(v1[2], v1[3]);
                    *(u32x4*)(rowp + bj * HALF) = w; } }
    }
};
__device__ __forceinline__ float sigmoid_f(float x) { return __builtin_amdgcn_rcpf(1.f + __builtin_amdgcn_exp2f(-1.44269504f * x)); }
__device__ __forceinline__ float bf_lo(unsigned w) { return __uint_as_float(w << 16); }
__device__ __forceinline__ float bf_hi(unsigned w) { return __uint_as_float(w & 0xffff0000u); }
typedef unsigned u32x2 __attribute__((ext_vector_type(2)));
enum { EM_BF16 = 0, EM_F32 = 1, EM_MERGE0 = 2, EM_MERGE1 = 3, EM_MOEA = 4 };
struct EpiU {
    static constexpr bool PERM = true, AFTER_DRAIN = false;
    int mode; bf16_t* O0; int ld0; int npn0; bf16_t* O1; int ld1; int pn_mask; int act; float scale; float* F; const bf16_t* G;
    __device__ __forceinline__ void operator()(const f32x4 (&acc)[2][2][4][2], const Unit& u, int wr, int wc, int fr, int fq) const {
        const int row0 = u.pm * BM + wr * 64 + fr;
        if (mode == EM_BF16) {
            int pn = u.pn & pn_mask; bf16_t* base = O0; int ldc = ld0; if (pn >= npn0) { pn -= npn0; base = O1; ldc = ld1; }
            const int col0 = pn * BM + wc * 32 + 8 * fq;
#pragma unroll
            for (int ai = 0; ai < 2; ++ai)
#pragma unroll
                for (int m = 0; m < 4; ++m) { bf16_t* rowp = base + (size_t)(row0 + ai * HALF + m * 16) * ldc + col0;
#pragma unroll
                    for (int bj = 0; bj < 2; ++bj) { f32x4 v0 = acc[ai][bj][m][0], v1 = acc[ai][bj][m][1];
                        if (act == 1) {
#pragma unroll
                            for (int q = 0; q < 4; ++q) { v0[q] = sigmoid_f(v0[q]); v1[q] = sigmoid_f(v1[q]); } }
                        v0 = v0 * scale; v1 = v1 * scale; u32x4 w; w.x = cvt_pk_bf16(v0[0], v0[1]); w.y = cvt_pk_bf16(v0[2], v0[3]); w.z = cvt_pk_bf16(v1[0], v1[1]); w.w = cvt_pk_bf16(v1[2], v1[3]);
                        *(u32x4*)(rowp + bj * HALF) = w; } }
        } else if (mode == EM_MOEA) {
            const int col0 = (u.pn & 3) * HALF + wc * 32 + 8 * fq;
#pragma unroll
            for (int ai = 0; ai < 2; ++ai)
#pragma unroll
                for (int m = 0; m < 4; ++m) { bf16_t* rowp = O0 + (size_t)(row0 + ai * HALF + m * 16) * 512 + col0;
                    f32x4 h0, h1;
#pragma unroll
                    for (int q = 0; q < 4; ++q) { const float g0 = acc[ai][0][m][0][q], g1 = acc[ai][0][m][1][q]; h0[q] = g0 * sigmoid_f(g0) * acc[ai][1][m][0][q]; h1[q] = g1 * sigmoid_f(g1) * acc[ai][1][m][1][q]; }
                    u32x4 w; w.x = cvt_pk_bf16(h0[0], h0[1]); w.y = cvt_pk_bf16(h0[2], h0[3]); w.z = cvt_pk_bf16(h1[0], h1[1]); w.w = cvt_pk_bf16(h1[2], h1[3]);
                    *(u32x4*)rowp = w; }
        } else {
            const int col0 = u.pn * BM + wc * 32 + 8 * fq;
#pragma unroll
            for (int ai = 0; ai < 2; ++ai)
#pragma unroll
                for (int m = 0; m < 4; ++m) { const size_t row = (size_t)(row0 + ai * HALF + m * 16);
#pragma unroll
                    for (int bj = 0; bj < 2; ++bj) { const int c = col0 + bj * HALF; f32x4 v0 = acc[ai][bj][m][0], v1 = acc[ai][bj][m][1];
                        if (mode != EM_F32) { const u32x4 gv = *(const u32x4*)(G + row * 2048 + (mode == EM_MERGE1 ? 1024 : 0) + c);
                            v0 = v0 * (f32x4){bf_lo(gv.x), bf_hi(gv.x), bf_lo(gv.y), bf_hi(gv.y)}; v1 = v1 * (f32x4){bf_lo(gv.z), bf_hi(gv.z), bf_lo(gv.w), bf_hi(gv.w)}; }
                        if (mode == EM_MERGE1) { v0 = v0 + *(const f32x4*)(F + row * 1024 + c); v1 = v1 + *(const f32x4*)(F + row * 1024 + c + 4);
                            u32x4 w; w.x = cvt_pk_bf16(v0[0], v0[1]); w.y = cvt_pk_bf16(v0[2], v0[3]); w.z = cvt_pk_bf16(v1[0], v1[1]); w.w = cvt_pk_bf16(v1[2], v1[3]); *(u32x4*)(O0 + row * 1024 + c) = w; }
                        else { *(f32x4*)(F + row * 1024 + c) = v0; *(f32x4*)(F + row * 1024 + c + 4) = v1; } } }
        }
    }
};
struct OrderU {
    StaticOrder st; int moe; const PG8_LAS int* tp;
    __device__ __forceinline__ bool next(int i, Unit& u) const {
        if (!moe) return st.next(i, u);
        const int L = i * st.G + st.c, tot = tp[16] * 4; if (L >= tot) return false;
        const int mt = L >> 2, nt = L & 3; int e = 0;
#pragma unroll
        for (int q = 1; q < 16; ++q) e += (mt >= tp[q]) ? 1 : 0;
        u.pm = mt; u.pn = e * 4 + nt; return true;
    }
    __device__ __forceinline__ void a_ready(const Unit&) const {}
    __device__ __forceinline__ void done(const Unit&) const {}
};
template <class Epi, class Sched, bool ALIGN_EPI = false, bool SP2 = false>
__device__ __forceinline__ void gemm_phase(PG8_LAS unsigned char* lds, const Gemm g, const Sched& S, const Epi& E) {
    const int tid = threadIdx.x, wid = __builtin_amdgcn_readfirstlane(tid >> 6), lane = tid & 63, wr = wid >> 2, wc = wid & 3, fr = lane & 15, fq = lane >> 4;
    const int K = g.K, nt = K / BK;
    unsigned voffA[2], voffB[2];
#pragma unroll
    for (int i = 0; i < 2; ++i) { int R, C; stage_rc(tid * 16 + i * 8192, R, C); const int Rb = Epi::PERM ? ((R & ~31) + perm32(R & 31)) : R;
        voffA[i] = (unsigned)(R * K + C) * 2u; voffB[i] = (unsigned)(Rb * K + C) * 2u; }
    const size_t kstep = (size_t)(BK * 2);
    const size_t hstep = (size_t)HALF * K * 2;
    const size_t tstep = 2 * hstep;
    const unsigned ldsw = (unsigned)wid * 1024u;
    const int aoff = lds_byte(wr * 64 + fr, fq * 8), boff = lds_byte(wc * 32 + fr, fq * 8);
#define PG8_SA(b, h) (((b) * 2 + (h)) * HTB)
#define PG8_SB(b, h) ((4 + (b) * 2 + (h)) * HTB)
#define PG8_STAGE(bufoff, gbase, voff) do { _Pragma("unroll") for (int _i = 0; _i < 2; ++_i) \
        __builtin_amdgcn_global_load_lds((const unsigned*)((const char*)(gbase) + (voff)[_i]), (PG8_LAS unsigned*)(lds + (bufoff) + ldsw + _i * 8192), 16, 0, 0); } while (0)
#define PG8_LDA(dst, b, h) do { _Pragma("unroll") for (int m = 0; m < 4; ++m) _Pragma("unroll") for (int k = 0; k < 2; ++k) dst[m][k] = *(const PG8_LAS bf16x8*)(lds + PG8_SA(b, h) + aoff + m * 2048 + k * 1024); } while (0)
#define PG8_LDB(dst, b, h) do { _Pragma("unroll") for (int n = 0; n < 2; ++n) _Pragma("unroll") for (int k = 0; k < 2; ++k) dst[n][k] = *(const PG8_LAS bf16x8*)(lds + PG8_SB(b, h) + boff + n * 2048 + k * 1024); } while (0)
#define PG8_MMA(ai, bj, At, Bt) do { __builtin_amdgcn_s_setprio(1); _Pragma("unroll") for (int m = 0; m < 4; ++m) _Pragma("unroll") for (int n = 0; n < 2; ++n) _Pragma("unroll") for (int k = 0; k < 2; ++k) \
        acc[ai][bj][m][n] = __builtin_amdgcn_mfma_f32_16x16x32_bf16(Bt[n][k], At[m][k], acc[ai][bj][m][n], 0, 0, 0); __builtin_amdgcn_s_setprio(0); } while (0)
#define PG8_WAIT_V(n) asm volatile("s_waitcnt vmcnt(" #n ")" ::: "memory")
#define PG8_WAIT_L(n) asm volatile("s_waitcnt lgkmcnt(" #n ")" ::: "memory")
#define PG8_BAR __builtin_amdgcn_s_barrier()
#define PG8_SCHED __builtin_amdgcn_sched_barrier(0)
    Unit cur, nxt; int ui = 0;
    if (!S.next(0, cur)) return;
    f32x4 acc[2][2][4][2];
#pragma unroll
    for (int a = 0; a < 2; ++a)
#pragma unroll
        for (int b = 0; b < 2; ++b)
#pragma unroll
            for (int m = 0; m < 4; ++m)
#pragma unroll
                for (int n = 0; n < 2; ++n) acc[a][b][m][n] = (f32x4){0.f, 0.f, 0.f, 0.f};
    bf16x8 At[4][2], B0[2][2], B1[2][2];
    const char* cA = (const char*)g.A + (size_t)cur.pm * tstep; const char* cB = (const char*)g.Bt + (size_t)cur.pn * tstep;
    S.a_ready(cur);
    if constexpr (SP2) {
        PG8_STAGE(PG8_SB(0, 0), cB, voffB); PG8_STAGE(PG8_SB(0, 1), cB + hstep, voffB); PG8_STAGE(PG8_SA(0, 0), cA, voffA); PG8_STAGE(PG8_SA(0, 1), cA + hstep, voffA);
        if (wr == 1) PG8_BAR;
        PG8_WAIT_V(2); PG8_BAR;
        PG8_STAGE(PG8_SB(1, 0), cB + kstep, voffB); PG8_STAGE(PG8_SA(1, 0), cA + kstep, voffA); PG8_STAGE(PG8_SB(1, 1), cB + hstep + kstep, voffB);
        PG8_WAIT_V(6); PG8_BAR;
    } else {
        PG8_STAGE(PG8_SB(0, 0), cB, voffB); PG8_STAGE(PG8_SA(0, 0), cA, voffA); PG8_STAGE(PG8_SB(0, 1), cB + hstep, voffB); PG8_STAGE(PG8_SA(0, 1), cA + hstep, voffA);
        if (wr == 1) PG8_BAR;
        PG8_WAIT_V(4); PG8_BAR;
        PG8_STAGE(PG8_SB(1, 0), cB + kstep, voffB); PG8_STAGE(PG8_SA(1, 0), cA + kstep, voffA); PG8_STAGE(PG8_SB(1, 1), cB + hstep + kstep, voffB);
        PG8_WAIT_V(6); PG8_BAR;
    }
    for (;;) {
        const bool has_next = S.next(ui + 1, nxt);
        const char* nA = has_next ? (const char*)g.A + (size_t)nxt.pm * tstep : cA; const char* nB = has_next ? (const char*)g.Bt + (size_t)nxt.pn * tstep : cB;
        for (int t = 0; t < nt; t += 2) {
            const bool last = (t == nt - 2);
            const char* a1 = cA + (size_t)(t + 1) * kstep;
            const char* a2 = last ? nA : cA + (size_t)(t + 2) * kstep; const char* b2 = last ? nB : cB + (size_t)(t + 2) * kstep;
            const char* a3 = a2 + kstep; const char* b3 = b2 + kstep;
            if (last && has_next) S.a_ready(nxt);
            if constexpr (SP2) {
            PG8_LDB(B0, 0, 0); PG8_LDB(B1, 0, 1); PG8_SCHED; PG8_LDA(At, 0, 0); PG8_STAGE(PG8_SA(1, 1), a1 + hstep, voffA);
            PG8_WAIT_V(8); PG8_WAIT_L(0); PG8_BAR; PG8_MMA(0, 0, At, B0); PG8_MMA(0, 1, At, B1); PG8_BAR; PG8_SCHED;
            PG8_LDA(At, 0, 1); PG8_STAGE(PG8_SB(0, 0), b2, voffB); PG8_STAGE(PG8_SB(0, 1), b2 + hstep, voffB); PG8_STAGE(PG8_SA(0, 0), a2, voffA);
            PG8_WAIT_V(8); PG8_WAIT_L(0); PG8_BAR; PG8_MMA(1, 0, At, B0); PG8_MMA(1, 1, At, B1); PG8_BAR; PG8_SCHED;
            PG8_LDB(B0, 1, 0); PG8_LDB(B1, 1, 1); PG8_SCHED; PG8_LDA(At, 1, 0); PG8_STAGE(PG8_SA(0, 1), a2 + hstep, voffA);
            PG8_WAIT_V(8); PG8_WAIT_L(0); PG8_BAR; PG8_MMA(0, 0, At, B0); PG8_MMA(0, 1, At, B1); PG8_BAR; PG8_SCHED;
            PG8_LDA(At, 1, 1); PG8_STAGE(PG8_SB(1, 0), b3, voffB); PG8_STAGE(PG8_SB(1, 1), b3 + hstep, voffB); PG8_STAGE(PG8_SA(1, 0), a3, voffA);
            PG8_WAIT_V(8); PG8_WAIT_L(0); PG8_BAR; PG8_MMA(1, 0, At, B0); PG8_MMA(1, 1, At, B1); PG8_BAR; PG8_SCHED;
            } else {
            PG8_LDB(B0, 0, 0); PG8_SCHED; PG8_LDA(At, 0, 0); PG8_STAGE(PG8_SA(1, 1), a1 + hstep, voffA);
            PG8_WAIT_L(8); PG8_BAR; PG8_WAIT_L(0); PG8_MMA(0, 0, At, B0); PG8_BAR; PG8_SCHED;
            PG8_LDB(B1, 0, 1); PG8_STAGE(PG8_SB(0, 0), b2, voffB);
            PG8_BAR; PG8_WAIT_L(0); PG8_MMA(0, 1, At, B1); PG8_BAR;
            PG8_LDA(At, 0, 1); PG8_STAGE(PG8_SA(0, 0), a2, voffA);
            PG8_BAR; PG8_WAIT_L(0); PG8_MMA(1, 0, At, B0); PG8_BAR; PG8_SCHED;
            PG8_STAGE(PG8_SB(0, 1), b2 + hstep, voffB);
            PG8_WAIT_V(6); PG8_BAR; PG8_MMA(1, 1, At, B1); PG8_BAR;
            PG8_LDB(B0, 1, 0); PG8_SCHED; PG8_LDA(At, 1, 0); PG8_STAGE(PG8_SA(0, 1), a2 + hstep, voffA);
            PG8_WAIT_L(8); PG8_BAR; PG8_WAIT_L(0); PG8_MMA(0, 0, At, B0); PG8_BAR; PG8_SCHED;
            PG8_LDB(B1, 1, 1); PG8_STAGE(PG8_SB(1, 0), b3, voffB);
            PG8_BAR; PG8_WAIT_L(0); PG8_MMA(0, 1, At, B1); PG8_BAR;
            PG8_LDA(At, 1, 1); PG8_STAGE(PG8_SA(1, 0), a3, voffA);
            PG8_BAR; PG8_WAIT_L(0); PG8_MMA(1, 0, At, B0); PG8_BAR; PG8_SCHED;
            PG8_STAGE(PG8_SB(1, 1), b3 + hstep, voffB);
            PG8_WAIT_V(6); PG8_BAR; PG8_MMA(1, 1, At, B1); PG8_BAR;
            }
        }
        if constexpr (ALIGN_EPI) { if (wr == 0) PG8_BAR; }
        if constexpr (!Epi::AFTER_DRAIN) { E(acc, cur, wr, wc, fr, fq); S.done(cur); }
        if (!has_next) break;
#pragma unroll
        for (int a = 0; a < 2; ++a)
#pragma unroll
            for (int b = 0; b < 2; ++b)
#pragma unroll
                for (int m = 0; m < 4; ++m)
#pragma unroll
                    for (int n = 0; n < 2; ++n) acc[a][b][m][n] = (f32x4){0.f, 0.f, 0.f, 0.f};
        cur = nxt; cA = nA; cB = nB; ++ui;
        if constexpr (ALIGN_EPI) { if (wr == 1) PG8_BAR; }
    }
    PG8_WAIT_V(0);
    if constexpr (!ALIGN_EPI) { if (wr == 0) PG8_BAR; }
    PG8_BAR;
    if constexpr (Epi::AFTER_DRAIN) { E.fused(acc, cur, wr, wc, fr, fq, lds, wid, lane); S.done(cur); }
#undef PG8_SA
#undef PG8_SB
#undef PG8_STAGE
#undef PG8_LDA
#undef PG8_LDB
#undef PG8_MMA
#undef PG8_WAIT_V
#undef PG8_WAIT_L
#undef PG8_BAR
#undef PG8_SCHED
}
}
constexpr int NWAVES = 8;
constexpr int BATCH = 8, SEQ = 2048, T = BATCH * SEQ, D = 1024, DEPTH = 2;
constexpr int RET_H = 4, RET_HD = 128, RET_W = 512, CHUNK = 64, NCHUNK = SEQ / CHUNK;
constexpr int RW_H = 8, RW_HD = 64, RW_W = 512, RW_COLS = 1792;
constexpr int N_IN = 5888, N1 = 3840, NGATE = 2048;
constexpr int MEM_LEN = 256, MEMT = BATCH * MEM_LEN, XA_H = 4, XA_HD = 256;
constexpr int NE = 16, DE = 512;
constexpr float ALPHA = 1.41421356237f;
constexpr float LN_EPS = 1e-5f, RW_GN_EPS = 64e-5f;
constexpr int N_PHASES = 1 + 15 * DEPTH;
#ifndef MK_ONE_LAUNCH
#define MK_ONE_LAUNCH 1
#endif

constexpr size_t MiB = 1u << 20;
constexpr size_t WS_CTL = 0, CTL_ZERO_BYTES = 1 * MiB;
constexpr size_t WS_ROPE = 1 * MiB;
constexpr size_t WS_LISTS = 2 * MiB;
constexpr size_t WS_TOKINFO = 3 * MiB;
constexpr size_t WS_RB = 3 * MiB + 512 * 1024;
constexpr size_t WS_MEMB = 4 * MiB;
constexpr size_t WS_WIN = 8 * MiB;
constexpr size_t WS_WRU = WS_WIN + (size_t)N_IN * D * 2;
constexpr size_t WS_WKU = WS_WRU + MiB;
constexpr size_t WS_WOUT = WS_WKU + MiB;
constexpr size_t WS_WQ = WS_WOUT + 2 * MiB;
constexpr size_t WS_WKV = WS_WQ + 2 * MiB;
constexpr size_t WS_WO = WS_WKV + 4 * MiB;
constexpr size_t WS_MK = 32 * MiB;
constexpr size_t WS_VT = 36 * MiB;
constexpr size_t WS_XN = 40 * MiB;
constexpr size_t AR = 72 * MiB;
constexpr size_t WS_PRET = AR, WS_PRW = AR + 64 * MiB, WS_SI = AR + 120 * MiB, WS_YR = AR + 216 * MiB, WS_YK = AR + 232 * MiB, WS_G = AR + 248 * MiB;
constexpr size_t WS_YRAW = AR, WS_PGATE = AR + 32 * MiB, WS_MRG = AR + 96 * MiB, WS_M1 = AR + 128 * MiB, WS_H1 = AR;
constexpr size_t WS_WMA = AR + 160 * MiB, WS_WMB = AR + 192 * MiB;
constexpr size_t WS_Q = AR + 64 * MiB, WS_O = AR + 96 * MiB;
constexpr size_t WS_XG = AR, WS_HM = AR + 72 * MiB, WS_YM = AR;
constexpr size_t WS_END = AR + 264 * MiB;
static_assert(WS_WO + 2 * MiB <= WS_MK, "ws map");
constexpr int MOE_MAXROWS = 2 * T + NE * 256;
static_assert((size_t)MOE_MAXROWS * 1024 * 2 <= 72 * MiB && (size_t)MOE_MAXROWS * 512 * 2 <= 36 * MiB, "moe buffers");
constexpr int CW_TMO = 0, CW_CODE = 1, CW_BAR = 4096, CW_CNT = 8192;

constexpr int LDS_BYTES = 147456, MISC_OFF = LDS_BYTES - 512;
#define GAS __attribute__((address_space(1)))
#define LAS __attribute__((address_space(3)))
typedef unsigned short bf16;
typedef unsigned v4u __attribute__((ext_vector_type(4)));
typedef float f32x4 __attribute__((ext_vector_type(4)));
typedef short bf16x8 __attribute__((ext_vector_type(8)));
typedef GAS unsigned gu32;
typedef GAS unsigned long long gu64;
#define RLX_AGENT __ATOMIC_RELAXED, __HIP_MEMORY_SCOPE_AGENT
#define LDS_WAIT() asm volatile("s_waitcnt lgkmcnt(0)" ::: "memory")
#define VM_WAIT() asm volatile("s_waitcnt vmcnt(0)" ::: "memory")
__device__ __forceinline__ unsigned long long rt() { return __builtin_amdgcn_s_memrealtime(); }
__device__ __forceinline__ unsigned f2bf(float f) { unsigned u = __builtin_bit_cast(unsigned, f); return (u + 0x7fffu + ((u >> 16) & 1u)) >> 16; }
__device__ __forceinline__ unsigned pk2(float lo, float hi) { return f2bf(lo) | (f2bf(hi) << 16); }

#define XB_TMO      128
#define XB_XCNT(j)  (256  + 64 * (j))
#define XB_XSUB(j)  (1280 + 64 * (j))
#define XB_XGEN(j)  (2304 + 64 * (j))
#define XB_TOP      3328
#define XB_TOPGEN   3392
#define XCD_BAR_WORDS 3456
#define XB_SPIN_CAP (1u << 18)

__device__ __forceinline__ unsigned xb_ld(unsigned* p)              { return __hip_atomic_load(p, __ATOMIC_RELAXED, __HIP_MEMORY_SCOPE_AGENT); }
__device__ __forceinline__ unsigned xb_add(unsigned* p, unsigned v) { return __hip_atomic_fetch_add(p, v, __ATOMIC_RELAXED, __HIP_MEMORY_SCOPE_AGENT); }
__device__ __forceinline__ unsigned xb_xcc_id() { return (unsigned)__builtin_amdgcn_s_getreg((3 << 11) | 20) & 0xFu; }
#define XB_SPIN(cond, bar) do { unsigned _sp = 0; while (cond) { __builtin_amdgcn_s_sleep(1); \
    if ((++_sp & 255u) == 0u) { if (xb_ld(&(bar)[XB_TMO])) break; if (_sp > XB_SPIN_CAP) { atomicAdd(&(bar)[XB_TMO], 1u); break; } } } } while (0)

struct XcdBarrier {
    unsigned* bar; unsigned x;
    volatile LAS unsigned* st;
};

__device__ __forceinline__ XcdBarrier xcd_barrier_post(unsigned* bar, volatile LAS unsigned* st) {
    XcdBarrier b; b.bar = bar; b.x = xb_xcc_id(); b.st = st;
    if (threadIdx.x == 0) (void)xb_add(&bar[XB_XCNT(b.x)], 1u);
    return b;
}
__device__ __forceinline__ void xcd_barrier_complete(unsigned* bar, unsigned x, unsigned& nloc, unsigned& nx) {
    const unsigned G = gridDim.x * gridDim.y * gridDim.z;
    unsigned sum, cnt, mine, sp = 0u;
    for (;;) {
        sum = 0u; cnt = 0u; mine = 0u;
#pragma unroll
        for (unsigned j = 0; j < 16; ++j) { const unsigned c = xb_ld(&bar[XB_XCNT(j)]); sum += c; cnt += (c > 0u) ? 1u : 0u; mine = (j == x) ? c : mine; }
        if (sum == G) break;
        __builtin_amdgcn_s_sleep(1);
        if ((++sp & 255u) == 0u) { if (xb_ld(&bar[XB_TMO])) break; if (sp > XB_SPIN_CAP) { atomicAdd(&bar[XB_TMO], 1u); break; } }
    }
    nloc = mine > 0u ? mine : 1u; nx = cnt > 0u ? cnt : 1u;
}

__device__ __forceinline__ void xcd_barrier(const XcdBarrier& b) {
    asm volatile("s_waitcnt vmcnt(0)" ::: "memory");
    __syncthreads();
    if (threadIdx.x == 0) {
        unsigned* bar = b.bar;
        __builtin_amdgcn_s_waitcnt(0);
        unsigned nloc = b.st[0], nx = b.st[1];
        if (nloc == 0u) { xcd_barrier_complete(bar, b.x, nloc, nx); b.st[0] = nloc; b.st[1] = nx; }
        const unsigned old = xb_add(&bar[XB_XSUB(b.x)], 1u);
        const unsigned gen = old / nloc;
        if (old + 1u == (gen + 1u) * nloc) {
            __builtin_amdgcn_fence(__ATOMIC_RELEASE, "agent");
            asm volatile("s_waitcnt vmcnt(0)" ::: "memory");
            const unsigned og = xb_add(&bar[XB_TOP], 1u);
            const unsigned tg = og / nx;
            if (og + 1u == (tg + 1u) * nx) xb_add(&bar[XB_TOPGEN], 1u);
            else XB_SPIN(xb_ld(&bar[XB_TOPGEN]) == tg, bar);
            __builtin_amdgcn_fence(__ATOMIC_ACQUIRE, "agent");
            xb_add(&bar[XB_XGEN(b.x)], 1u);
            asm volatile("s_waitcnt vmcnt(0)" ::: "memory");
        } else {
            XB_SPIN(xb_ld(&bar[XB_XGEN(b.x)]) == gen, bar);
            __builtin_amdgcn_fence(__ATOMIC_ACQUIRE, "agent");
            asm volatile("s_waitcnt vmcnt(0)" ::: "memory");
        }
    }
    __syncthreads();
}
typedef unsigned u32x2 __attribute__((ext_vector_type(2)));
struct Args { const float* in[34]; float* out; unsigned char* ws; int ph_lo, ph_hi; };
typedef const __attribute__((address_space(4))) Args* KArgs;
#define IN(i) (A->in[i])
struct Frame {
    LAS unsigned char* lds; volatile LAS unsigned* MISC; gu32* ctl;
    int tid, lane, wave, vcu, G;
    float* X; unsigned char* ws;
};
__device__ __forceinline__ float wave_sum(float v) {
#pragma unroll
    for (int o = 1; o < 64; o <<= 1) v += __shfl_xor(v, o);
    return v;
}
#define DPP_F(x, ctrl) __int_as_float(__builtin_amdgcn_update_dpp(0, __float_as_int(x), (ctrl), 0xF, 0xF, true))
__device__ __forceinline__ float row_sum16(float x) {
    x += DPP_F(x, 0xB1); x += DPP_F(x, 0x4E); x += DPP_F(x, 0x141); x += DPP_F(x, 0x140); return x;
}
__device__ __forceinline__ float row_sum8(float x) {
    x += DPP_F(x, 0xB1); x += DPP_F(x, 0x4E); x += DPP_F(x, 0x141); return x;
}
__device__ __forceinline__ float sigm(float x) { return __builtin_amdgcn_rcpf(1.f + __builtin_amdgcn_exp2f(-1.44269504f * x)); }
__device__ __forceinline__ float bfl(unsigned w) { return __uint_as_float(w << 16); }
__device__ __forceinline__ float bfh(unsigned w) { return __uint_as_float(w & 0xffff0000u); }
__device__ __forceinline__ float bf1(bf16 h) { return __uint_as_float((unsigned)h << 16); }

__device__ __forceinline__ void transpose_block(const float* W, int ldw, int k0, int n0, bf16* WT, int ldt, int drow0, LAS float* scr, int lane) {
#pragma unroll 8
    for (int i = 0; i < 32; ++i) { const int kk = 2 * i + (lane >> 5); scr[kk * 33 + (lane & 31)] = W[(size_t)(k0 + kk) * ldw + n0 + (lane & 31)]; }
    LDS_WAIT(); asm volatile("" ::: "memory");
    const int c = lane & 7;
#pragma unroll
    for (int j = 0; j < 4; ++j) { const int n = (lane >> 3) + 8 * j; const LAS float* s = scr + (8 * c) * 33 + n;
        v4u o; o.x = pk2(s[0 * 33], s[1 * 33]); o.y = pk2(s[2 * 33], s[3 * 33]); o.z = pk2(s[4 * 33], s[5 * 33]); o.w = pk2(s[6 * 33], s[7 * 33]);
        *(GAS v4u*)(WT + (size_t)(drow0 + n) * ldt + k0 + 8 * c) = o; }
    LDS_WAIT(); asm volatile("" ::: "memory");
}
__device__ __forceinline__ void convert_wa(KArgs A, Frame& F, int l) {
    LAS float* scr = (LAS float*)(F.lds + F.wave * 16384);
    const int gw = F.vcu * NWAVES + F.wave, NGW = F.G * NWAVES;
    constexpr int I0 = 16 * 184, I1 = 8 * 32, I3 = 16 * 32, I5 = 16 * 64;
    constexpr int NIT = I0 + 2 * I1 + 3 * I3 + I5;
    for (int it = gw; it < NIT; it += NGW) {
        int r = it; const float* W; int K, N; bf16* dst;
        if (r < I0) { W = IN(6) + (size_t)l * D * N_IN; K = D; N = N_IN; dst = (bf16*)(F.ws + WS_WIN); }
        else if ((r -= I0) < I1) { W = IN(19) + (size_t)l * RET_W * D; K = RET_W; N = D; dst = (bf16*)(F.ws + WS_WRU); }
        else if ((r -= I1) < I1) { W = IN(20) + (size_t)l * RW_W * D; K = RW_W; N = D; dst = (bf16*)(F.ws + WS_WKU); }
        else if ((r -= I1) < I3) { W = IN(21) + (size_t)l * D * D; K = D; N = D; dst = (bf16*)(F.ws + WS_WOUT); }
        else if ((r -= I3) < I3) { W = IN(24) + (size_t)l * D * D; K = D; N = D; dst = (bf16*)(F.ws + WS_WQ); }
        else if ((r -= I3) < I5) { W = IN(25) + (size_t)l * D * 2 * D; K = D; N = 2 * D; dst = (bf16*)(F.ws + WS_WKV); }
        else { r -= I5; W = IN(26) + (size_t)l * D * D; K = D; N = D; dst = (bf16*)(F.ws + WS_WO); }
        const int nblk = N / 32, kb = r / nblk, nb = r % nblk;
        transpose_block(W, N, 64 * kb, 32 * nb, dst, K, 32 * nb, scr, F.lane);
    }
}
__device__ __forceinline__ void convert_wm(KArgs A, Frame& F, int l) {
    LAS float* scr = (LAS float*)(F.lds + F.wave * 16384);
    const int gw = F.vcu * NWAVES + F.wave, NGW = F.G * NWAVES;
    constexpr int IE = 256;
    for (int it = gw; it < NE * 3 * IE; it += NGW) {
        const int e = it / (3 * IE), r3 = it % (3 * IE), which = r3 / IE, r = r3 % IE;
        if (which < 2) {
            const float* W = (which == 0 ? IN(29) : IN(30)) + ((size_t)l * NE + e) * D * DE;
            const int kb = r / 16, nb = r % 16, n0 = 32 * nb;
            const int drow0 = e * 1024 + (n0 >> 7) * 256 + which * 128 + (n0 & 127);
            transpose_block(W, DE, 64 * kb, n0, (bf16*)(F.ws + WS_WMA), D, drow0, scr, F.lane);
        } else {
            const float* W = IN(31) + ((size_t)l * NE + e) * DE * D;
            const int kb = r / 32, nb = r % 32, n0 = 32 * nb;
            transpose_block(W, D, 64 * kb, n0, (bf16*)(F.ws + WS_WMB), DE, e * 1024 + n0, scr, F.lane);
        }
    }
}
__device__ __forceinline__ void ln_store(f32x4 (&v)[4], const float* g, const float* b, float* xo, bf16* xn, int lane) {
    float s = 0.f;
#pragma unroll
    for (int j = 0; j < 4; ++j) s += (v[j].x + v[j].y) + (v[j].z + v[j].w);
    const float mean = wave_sum(s) * (1.f / D); float s2 = 0.f;
#pragma unroll
    for (int j = 0; j < 4; ++j) { v[j] = v[j] - mean; s2 += (v[j].x * v[j].x + v[j].y * v[j].y) + (v[j].z * v[j].z + v[j].w * v[j].w); }
    const float rstd = 1.f / sqrtf(wave_sum(s2) * (1.f / D) + LN_EPS);
#pragma unroll
    for (int j = 0; j < 4; ++j) { const f32x4 gg = *(const f32x4*)(g + 4 * lane + 256 * j), bb = *(const f32x4*)(b + 4 * lane + 256 * j);
        v[j] = v[j] * rstd * gg + bb;
        *(f32x4*)(xo + 4 * lane + 256 * j) = v[j];
        u32x2 w; w.x = pk2(v[j].x, v[j].y); w.y = pk2(v[j].z, v[j].w); *(u32x2*)(xn + 4 * lane + 256 * j) = w; }
}
__device__ __forceinline__ void p0_prologue(KArgs A, Frame& F) {
    convert_wa(A, F, 0);
    const int gw = F.vcu * NWAVES + F.wave, NGW = F.G * NWAVES, lane = F.lane;
    for (int m = gw; m < T; m += NGW) {
        const float* xr = IN(0) + (size_t)m * D; f32x4 v[4];
#pragma unroll
        for (int j = 0; j < 4; ++j) v[j] = *(const f32x4*)(xr + 4 * lane + 256 * j);
        ln_store(v, IN(2), IN(3), F.X + (size_t)m * D, (bf16*)(F.ws + WS_XN) + (size_t)m * D, lane);
    }
    for (int m = gw; m < MEMT; m += NGW) {
        const float* xr = IN(1) + (size_t)m * D; bf16* o = (bf16*)(F.ws + WS_MEMB) + (size_t)m * D;
#pragma unroll
        for (int j = 0; j < 4; ++j) { const f32x4 v = *(const f32x4*)(xr + 4 * lane + 256 * j); u32x2 w; w.x = pk2(v.x, v.y); w.y = pk2(v.z, v.w); *(u32x2*)(o + 4 * lane + 256 * j) = w; }
    }
    float* ctab = (float*)(F.ws + WS_ROPE); float* stab = ctab + SEQ * 64;
    for (int i = blockIdx.x * (NWAVES * 64) + F.tid; i < SEQ * 64; i += F.G * NWAVES * 64) {
        const int pos = i >> 6, j = i & 63;
        const float invf = exp2f(-(float)j * (13.287712379549449f / 64.f));
        const double rev = (double)((float)pos * invf) * 0.15915494309189535;
        const float fr = (float)(rev - floor(rev));
        ctab[i] = __builtin_amdgcn_cosf(fr); stab[i] = __builtin_amdgcn_sinf(fr);
    }
}

__device__ __forceinline__ void rwkv_prep(KArgs A, Frame& F, int l, int bi, int nb) {
    const int tid = F.tid, lane = F.lane;
    const int cb = bi & 3;
    LAS bf16* wl = (LAS bf16*)F.lds; LAS float* act = (LAS float*)(F.lds + 65536);
    const float* wup = IN(9) + (size_t)l * 64 * RW_W; const float* aup = IN(11) + (size_t)l * 64 * RW_W; const float* gup = IN(13) + (size_t)l * 128 * RW_W;
    for (int i = tid; i < 256 * 128; i += NWAVES * 64) { const int k = i >> 7, c = i & 127;
        const float v = (k < 64) ? wup[(size_t)k * RW_W + 128 * cb + c] : (k < 128) ? aup[(size_t)(k - 64) * RW_W + 128 * cb + c] : gup[(size_t)(k - 128) * RW_W + 128 * cb + c];
        wl[i] = (bf16)f2bf(v); }
    const bf16* P = (const bf16*)(F.ws + WS_PRW);
    const float* mu = IN(8) + (size_t)l * RW_COLS;
    const float* w0 = IN(10) + (size_t)l * RW_W; const float* a0 = IN(12) + (size_t)l * RW_W;
    const float* k_k = IN(14) + (size_t)l * RW_W; const float* k_a = IN(15) + (size_t)l * RW_W; const float* r_k = IN(16) + (size_t)l * RW_W;
    bf16* SI = (bf16*)(F.ws + WS_SI); bf16* Gb = (bf16*)(F.ws + WS_G); float* RB = (float*)(F.ws + WS_RB);
    const int cg = tid & 31, tg = tid >> 5;
    for (int tt = (bi >> 2); tt < T / 64; tt += (nb >> 2)) {
        __syncthreads();
        {
            const int c = tid >> 3, p = tid & 7; const int t = 64 * tt + c; const bool first = (t & (SEQ - 1)) == 0;
            const bf16* pr = P + (size_t)t * RW_COLS + 1536 + 32 * p; const bf16* pp = pr - RW_COLS;
#pragma unroll 1
            for (int q = 0; q < 4; ++q) {
                const v4u a = *(const v4u*)(pr + 8 * q); v4u b = {0u, 0u, 0u, 0u}; if (!first) b = *(const v4u*)(pp + 8 * q);
                const unsigned aw[4] = {a.x, a.y, a.z, a.w}, bw[4] = {b.x, b.y, b.z, b.w};
#pragma unroll
                for (int z = 0; z < 8; ++z) { const int i = 32 * p + 8 * q + z;
                    const float cur = (z & 1) ? bfh(aw[z >> 1]) : bfl(aw[z >> 1]), prv = (z & 1) ? bfh(bw[z >> 1]) : bfl(bw[z >> 1]);
                    float x = cur + mu[1536 + i] * (prv - cur);
                    if (i < 64) { const float e2 = __builtin_amdgcn_exp2f(2.f * 1.44269504f * x); x = 1.f - 2.f * __builtin_amdgcn_rcpf(e2 + 1.f); }
                    else if (i >= 128) x = __builtin_amdgcn_rcpf(1.f + __builtin_amdgcn_exp2f(-1.44269504f * x));
                    act[i * 64 + c] = x; }
            }
        }
        __syncthreads();
        float ww[4][4], aa[4][4], gg[4][4];
#pragma unroll
        for (int a = 0; a < 4; ++a)
#pragma unroll
            for (int b = 0; b < 4; ++b) { ww[a][b] = 0.f; aa[a][b] = 0.f; gg[a][b] = 0.f; }
#pragma unroll 4
        for (int k = 0; k < 64; ++k) {
            const f32x4 x1 = *(const LAS f32x4*)(act + k * 64 + 4 * tg), x2 = *(const LAS f32x4*)(act + (64 + k) * 64 + 4 * tg);
            const u32x2 w1 = *(const LAS u32x2*)(wl + k * 128 + 4 * cg), w2 = *(const LAS u32x2*)(wl + (64 + k) * 128 + 4 * cg);
            const float c1[4] = {bfl(w1.x), bfh(w1.x), bfl(w1.y), bfh(w1.y)}, c2[4] = {bfl(w2.x), bfh(w2.x), bfl(w2.y), bfh(w2.y)};
#pragma unroll
            for (int a = 0; a < 4; ++a)
#pragma unroll
                for (int b = 0; b < 4; ++b) { ww[a][b] += x1[a] * c1[b]; aa[a][b] += x2[a] * c2[b]; }
        }
#pragma unroll 4
        for (int k = 0; k < 128; ++k) {
            const f32x4 x3 = *(const LAS f32x4*)(act + (128 + k) * 64 + 4 * tg);
            const u32x2 w3 = *(const LAS u32x2*)(wl + (128 + k) * 128 + 4 * cg);
            const float c3[4] = {bfl(w3.x), bfh(w3.x), bfl(w3.y), bfh(w3.y)};
#pragma unroll
            for (int a = 0; a < 4; ++a)
#pragma unroll
                for (int b = 0; b < 4; ++b) gg[a][b] += x3[a] * c3[b];
        }
        const int col0 = 128 * cb + 4 * cg, h = col0 >> 6, kidx = col0 & 63;
        __syncthreads();
        {
            const f32x4 w0v = *(const f32x4*)(w0 + col0), a0v = *(const f32x4*)(a0 + col0);
#pragma unroll
            for (int a = 0; a < 4; ++a) {
                *(LAS f32x4*)(act + (4 * tg + a) * 128 + 4 * cg) = (f32x4){ww[a][0] + w0v[0], ww[a][1] + w0v[1], ww[a][2] + w0v[2], ww[a][3] + w0v[3]};
                *(LAS f32x4*)(act + 8192 + (4 * tg + a) * 128 + 4 * cg) = (f32x4){aa[a][0] + a0v[0], aa[a][1] + a0v[1], aa[a][2] + a0v[2], aa[a][3] + a0v[3]};
                u32x2 o; o.x = pk2(gg[a][0], gg[a][1]); o.y = pk2(gg[a][2], gg[a][3]); *(u32x2*)(Gb + (size_t)(64 * tt + 4 * tg + a) * RW_W + col0) = o;
            }
        }
#pragma unroll 1
        for (int a = 0; a < 4; ++a) {
            const f32x4 kkv = *(const f32x4*)(k_k + col0), kav = *(const f32x4*)(k_a + col0), rkv = *(const f32x4*)(r_k + col0);
            const f32x4 mur = *(const f32x4*)(mu + col0), muk = *(const f32x4*)(mu + 512 + col0), muv = *(const f32x4*)(mu + 1024 + col0);
            const f32x4 wv4 = *(const LAS f32x4*)(act + (4 * tg + a) * 128 + 4 * cg), av4 = *(const LAS f32x4*)(act + 8192 + (4 * tg + a) * 128 + 4 * cg);
            const int t = 64 * tt + 4 * tg + a; const bool first = (t & (SEQ - 1)) == 0; const int b = t >> 11, s = t & (SEQ - 1);
            const bf16* pr = P + (size_t)t * RW_COLS + col0; const bf16* pp = pr - RW_COLS;
            const u32x2 r2 = *(const u32x2*)pr, k2 = *(const u32x2*)(pr + 512), v2 = *(const u32x2*)(pr + 1024);
            u32x2 rp = {0u, 0u}, kp = {0u, 0u}, vp = {0u, 0u}; if (!first) { rp = *(const u32x2*)pp; kp = *(const u32x2*)(pp + 512); vp = *(const u32x2*)(pp + 1024); }
            const float rc[4] = {bfl(r2.x), bfh(r2.x), bfl(r2.y), bfh(r2.y)}, rq[4] = {bfl(rp.x), bfh(rp.x), bfl(rp.y), bfh(rp.y)};
            const float kc[4] = {bfl(k2.x), bfh(k2.x), bfl(k2.y), bfh(k2.y)}, kq[4] = {bfl(kp.x), bfh(kp.x), bfl(kp.y), bfh(kp.y)};
            const float vc[4] = {bfl(v2.x), bfh(v2.x), bfl(v2.y), bfh(v2.y)}, vq[4] = {bfl(vp.x), bfh(vp.x), bfl(vp.y), bfh(vp.y)};
            float r[4], k[4], v[4], kk[4], om[4], av[4]; float ssq = 0.f;
#pragma unroll
            for (int c = 0; c < 4; ++c) {
                r[c] = rc[c] + mur[c] * (rq[c] - rc[c]); k[c] = kc[c] + muk[c] * (kq[c] - kc[c]); v[c] = vc[c] + muv[c] * (vq[c] - vc[c]);
                const float wv = wv4[c];
                const float wlog = -0.69314718f * __builtin_amdgcn_logf(1.f + __builtin_amdgcn_exp2f(-1.44269504f * wv)) - 0.5f;
                const float e = __builtin_amdgcn_exp2f(1.44269504f * wlog);
                om[c] = 1.f - __builtin_amdgcn_exp2f(-1.44269504f * e);
                av[c] = __builtin_amdgcn_rcpf(1.f + __builtin_amdgcn_exp2f(-1.44269504f * av4[c]));
                kk[c] = k[c] * kkv[c]; ssq += kk[c] * kk[c];
            }
            ssq = row_sum16(ssq);
            const float rn = 1.f / fmaxf(sqrtf(ssq), 1e-12f);
            float kt[4], nbv[4]; float bon = 0.f;
#pragma unroll
            for (int c = 0; c < 4; ++c) { kk[c] *= rn; kt[c] = k[c] * (1.f + (av[c] - 1.f) * kav[c]); nbv[c] = -kk[c] * av[c]; bon += r[c] * kt[c] * rkv[c]; }
            bon = row_sum16(bon);
            if ((cg & 15) == 0) RB[(size_t)t * 8 + h] = bon;
            bf16* sp = SI + ((size_t)(b * RW_H + h) * SEQ + s) * 384 + kidx;
            u32x2 o;
            o.x = pk2(r[0], r[1]); o.y = pk2(r[2], r[3]); *(u32x2*)(sp) = o;
            o.x = pk2(kt[0], kt[1]); o.y = pk2(kt[2], kt[3]); *(u32x2*)(sp + 64) = o;
            o.x = pk2(kk[0], kk[1]); o.y = pk2(kk[2], kk[3]); *(u32x2*)(sp + 128) = o;
            o.x = pk2(nbv[0], nbv[1]); o.y = pk2(nbv[2], nbv[3]); *(u32x2*)(sp + 192) = o;
            o.x = pk2(om[0], om[1]); o.y = pk2(om[2], om[3]); *(u32x2*)(sp + 256) = o;
            o.x = pk2(v[0], v[1]); o.y = pk2(v[2], v[3]); *(u32x2*)(sp + 320) = o;
        }
    }
    __syncthreads();
}
__device__ __forceinline__ unsigned off_b(unsigned row, unsigned ch) { return 256u * row + 16u * (ch ^ (((row & 3u) << 2) | ((row >> 2) & 3u))); }
__device__ __forceinline__ void retention_unit(KArgs A, Frame& F, int l, int bh) {
    typedef float f32x16 __attribute__((ext_vector_type(16))); typedef short s16x4 __attribute__((ext_vector_type(4))); typedef short v4i16_t __attribute__((ext_vector_type(4)));
    const int tid = F.tid, lane = F.lane, wave = F.wave, r = lane & 31, hh = lane >> 5, cb = wave >> 2, eb = wave & 3;
    const int b = bh >> 2, h = bh & 3;
    LAS unsigned char* Qs = F.lds; LAS unsigned char* Ks = F.lds + 16384; LAS unsigned char* Kd = F.lds + 32768; LAS unsigned char* Vs = F.lds + 49152; LAS unsigned char* Gs = F.lds + 65536;
    LAS unsigned char* Stt = F.lds + 81920; LAS float* red1 = (LAS float*)(F.lds + 114688); LAS float* red2 = (LAS float*)(F.lds + 115712);
    const bf16* P = (const bf16*)(F.ws + WS_PRET); bf16* YR = (bf16*)(F.ws + WS_YR);
    const float* ctab = (const float*)(F.ws + WS_ROPE); const float* stab = ctab + SEQ * 64;
    const float gnw = (IN(7) + (size_t)l * RET_W + h * RET_HD)[32 * eb + r];
    const float lg = __builtin_amdgcn_logf(1.f - exp2f(-5.f - (float)h));
    const float gC = exp2f(lg * 64.f);
    { unsigned z_ = 0u; asm volatile("" : "+v"(z_)); for (int i = tid; i < 32768 / 16; i += NWAVES * 64) ((LAS v4u*)Stt)[i] = (v4u){z_, z_, z_, z_}; }
    f32x16 st0, st1;
#pragma unroll
    for (int i = 0; i < 16; ++i) { st0[i] = 0.f; st1[i] = 0.f; }
    const int sc = tid >> 3, sp = tid & 7;
    const int blk = (lane >> 4) & 1, tq = (lane & 15) >> 2, tp = lane & 3;
    const unsigned fr = ((r & 3) << 2) | ((r >> 2) & 3), fs = ((sc & 3) << 2) | ((sc >> 2) & 3);
    const unsigned lds0 = (unsigned)(uintptr_t)F.lds;
    unsigned aQ = lds0 + 256 * (32 * cb + r) + 16 * (hh ^ fr);
    unsigned aK = lds0 + 16384 + 256 * r + 16 * (hh ^ fr);
    unsigned aS = lds0 + 81920 + 256 * (32 * eb + r) + 16 * (hh ^ fr);
    unsigned aV2 = lds0 + 49152 + 256 * (4 * hh + tq) + 16 * ((4 * eb + 2 * blk + (tp >> 1)) ^ ((tq << 2) | hh)) + 8 * (tp & 1);
    unsigned aV4 = lds0 + 49152 + 256 * (8 * hh + tq) + 16 * ((4 * eb + 2 * blk + (tp >> 1)) ^ ((tq << 2) | (2 * hh))) + 8 * (tp & 1);
    unsigned aK4 = lds0 + 32768 + 256 * (8 * hh + tq) + 16 * ((8 * cb + 2 * blk + (tp >> 1)) ^ ((tq << 2) | (2 * hh))) + 8 * (tp & 1);
    unsigned aW = lds0 + 81920 + 256 * (32 * eb + r) + 16 * ((8 * cb) ^ fr) + 8 * hh;
    unsigned aW1 = lds0 + 256 * sc + 16 * (sp ^ fs);
    unsigned aWv = lds0 + 49152 + 256 * sc + 16 * ((2 * sp) ^ fs);
    unsigned aG = lds0 + 65536 + 256 * (32 * cb + 4 * hh) + 2 * (32 * eb + r);
    unsigned aR = lds0 + 114688 + 16 * (32 * cb + 4 * hh);
#define LD128(a) (*(const LAS bf16x8*)(uintptr_t)(a))
#define LDTR(a) __builtin_bit_cast(s16x4, __builtin_amdgcn_ds_read_tr16_b64_v4i16((LAS v4i16_t*)(uintptr_t)(a)))
    v4u fq1, fq2, fk1, fk2, fv1, fv2, fg1, fg2; f32x4 pc0, pc1, ps0, ps1;
#define RET_LOAD(n) do { const int s_ = (n) * CHUNK + sc; const bf16* pr_ = P + ((size_t)b * SEQ + s_) * 2048 + h * RET_HD; \
        fq1 = *(const v4u*)(pr_ + 8 * sp); fq2 = *(const v4u*)(pr_ + 64 + 8 * sp); fk1 = *(const v4u*)(pr_ + 512 + 8 * sp); fk2 = *(const v4u*)(pr_ + 576 + 8 * sp); \
        fv1 = *(const v4u*)(pr_ + 1024 + 16 * sp); fv2 = *(const v4u*)(pr_ + 1032 + 16 * sp); } while (0)
#define RET_LOAD2(n) do { const int s_ = (n) * CHUNK + sc; const bf16* pr_ = P + ((size_t)b * SEQ + s_) * 2048 + h * RET_HD; fg1 = *(const v4u*)(pr_ + 1536 + 16 * sp); fg2 = *(const v4u*)(pr_ + 1544 + 16 * sp); \
        pc0 = *(const f32x4*)(ctab + s_ * 64 + 8 * sp); pc1 = *(const f32x4*)(ctab + s_ * 64 + 8 * sp + 4); ps0 = *(const f32x4*)(stab + s_ * 64 + 8 * sp); ps1 = *(const f32x4*)(stab + s_ * 64 + 8 * sp + 4); } while (0)
    RET_LOAD(0);
    const int cpos = 32 * cb + r;
#pragma unroll 1
    for (int n = 0; n < NCHUNK; ++n) {
        asm volatile("" : "+v"(aQ), "+v"(aK), "+v"(aS), "+v"(aV2), "+v"(aV4), "+v"(aK4), "+v"(aW), "+v"(aW1), "+v"(aWv), "+v"(aG), "+v"(aR));
        RET_LOAD2(n);
        __syncthreads();
        {
            const unsigned qa[4] = {fq1.x, fq1.y, fq1.z, fq1.w}, qb[4] = {fq2.x, fq2.y, fq2.z, fq2.w}, ka[4] = {fk1.x, fk1.y, fk1.z, fk1.w}, kb[4] = {fk2.x, fk2.y, fk2.z, fk2.w};
            const float cs[8] = {pc0.x, pc0.y, pc0.z, pc0.w, pc1.x, pc1.y, pc1.z, pc1.w}, sn[8] = {ps0.x, ps0.y, ps0.z, ps0.w, ps1.x, ps1.y, ps1.z, ps1.w};
            const float kdec = __builtin_amdgcn_exp2f(lg * (float)(63 - sc));
            unsigned o1[4], o2[4], o3[4], o4[4], o5[4], o6[4];
#pragma unroll
            for (int z = 0; z < 4; ++z) {
                const float a0 = bfl(qa[z]), a1 = bfh(qa[z]), b0 = bfl(qb[z]), b1 = bfh(qb[z]);
                o1[z] = pk2(a0 * cs[2 * z] - b0 * sn[2 * z], a1 * cs[2 * z + 1] - b1 * sn[2 * z + 1]);
                o2[z] = pk2(a0 * sn[2 * z] + b0 * cs[2 * z], a1 * sn[2 * z + 1] + b1 * cs[2 * z + 1]);
                const float e0 = bfl(ka[z]) * 0.08838834764831845f, e1 = bfh(ka[z]) * 0.08838834764831845f, f0 = bfl(kb[z]) * 0.08838834764831845f, f1 = bfh(kb[z]) * 0.08838834764831845f;
                const float x0 = e0 * cs[2 * z] - f0 * sn[2 * z], x1 = e1 * cs[2 * z + 1] - f1 * sn[2 * z + 1], y0 = e0 * sn[2 * z] + f0 * cs[2 * z], y1 = e1 * sn[2 * z + 1] + f1 * cs[2 * z + 1];
                o3[z] = pk2(x0, x1); o4[z] = pk2(y0, y1); o5[z] = pk2(x0 * kdec, x1 * kdec); o6[z] = pk2(y0 * kdec, y1 * kdec);
            }
#define ST128(a, v) (*(LAS v4u*)(uintptr_t)(a) = (v))
            ST128(aW1, ((v4u){o1[0], o1[1], o1[2], o1[3]})); ST128(aW1 ^ 128, ((v4u){o2[0], o2[1], o2[2], o2[3]}));
            ST128(aW1 + 16384, ((v4u){o3[0], o3[1], o3[2], o3[3]})); ST128((aW1 ^ 128) + 16384, ((v4u){o4[0], o4[1], o4[2], o4[3]}));
            ST128(aW1 + 32768, ((v4u){o5[0], o5[1], o5[2], o5[3]})); ST128((aW1 ^ 128) + 32768, ((v4u){o6[0], o6[1], o6[2], o6[3]}));
            ST128(aWv, fv1); ST128(aWv ^ 16, fv2);
            *(LAS v4u*)(Gs + sc * 256 + 32 * sp) = fg1; *(LAS v4u*)(Gs + sc * 256 + 32 * sp + 16) = fg2;
        }
        if (n + 1 < NCHUNK) RET_LOAD(n + 1);
        __syncthreads();
        bf16x8 qf[8];
#pragma unroll
        for (int s = 0; s < 8; ++s) qf[s] = LD128(aQ ^ (32 * s));
        f32x16 p0, p1;
#pragma unroll
        for (int i = 0; i < 16; ++i) { p0[i] = 0.f; p1[i] = 0.f; }
#pragma unroll
        for (int s = 0; s < 8; ++s) { const bf16x8 a0 = LD128(aK ^ (32 * s)), a1 = LD128((aK ^ (32 * s)) + 8192);
            p0 = __builtin_amdgcn_mfma_f32_32x32x16_bf16(a0, qf[s], p0, 0, 0, 0); p1 = __builtin_amdgcn_mfma_f32_32x32x16_bf16(a1, qf[s], p1, 0, 0, 0); }
#pragma unroll
        for (int i = 0; i < 16; ++i) { const int m0 = (i & 3) + 8 * (i >> 2) + 4 * hh; const int d0 = cpos > m0 ? cpos - m0 : m0 - cpos, d1 = cpos > m0 + 32 ? cpos - m0 - 32 : m0 + 32 - cpos;
            p0[i] *= __builtin_amdgcn_exp2f(lg * (float)d0); p1[i] *= __builtin_amdgcn_exp2f(lg * (float)d1); }
        bf16x8 pf[4];
#pragma unroll
        for (int s = 0; s < 4; ++s) { const int o = 8 * (s & 1); v4u w;
            if (s < 2) { w.x = pk2(p0[o + 0], p0[o + 1]); w.y = pk2(p0[o + 2], p0[o + 3]); w.z = pk2(p0[o + 4], p0[o + 5]); w.w = pk2(p0[o + 6], p0[o + 7]); }
            else { w.x = pk2(p1[o + 0], p1[o + 1]); w.y = pk2(p1[o + 2], p1[o + 3]); w.z = pk2(p1[o + 4], p1[o + 5]); w.w = pk2(p1[o + 6], p1[o + 7]); }
            pf[s] = __builtin_bit_cast(bf16x8, w); }
        f32x16 yi;
#pragma unroll
        for (int i = 0; i < 16; ++i) yi[i] = 0.f;
#pragma unroll
        for (int s = 0; s < 4; ++s) {
            const s16x4 lo = LDTR(aV2 + 4096 * s), hi = LDTR((aV2 ^ 32) + 2048 + 4096 * s);
            const bf16x8 vf = {lo[0], lo[1], lo[2], lo[3], hi[0], hi[1], hi[2], hi[3]};
            yi = __builtin_amdgcn_mfma_f32_32x32x16_bf16(pf[s], vf, yi, 0, 0, 0); }
        f32x16 yc;
#pragma unroll
        for (int i = 0; i < 16; ++i) yc[i] = 0.f;
#pragma unroll
        for (int s = 0; s < 8; ++s) { const bf16x8 sf = LD128(aS ^ (32 * s)); yc = __builtin_amdgcn_mfma_f32_32x32x16_bf16(qf[s], sf, yc, 0, 0, 0); }
#pragma unroll
        for (int i = 0; i < 16; ++i) { const int c = 32 * cb + (i & 3) + 8 * (i >> 2) + 4 * hh; yi[i] += __builtin_amdgcn_exp2f(lg * (float)(c + 1)) * yc[i]; }
#pragma unroll
        for (int i = 0; i < 16; ++i) { float s1 = row_sum16(yi[i]), s2 = row_sum16(yi[i] * yi[i]); s1 += __shfl_xor(s1, 16); s2 += __shfl_xor(s2, 16);
            if (r == 0) { LAS float* rp = (LAS float*)(uintptr_t)(aR + 16 * ((i & 3) + 8 * (i >> 2)) + 4 * eb); rp[0] = s1; rp[256] = s2; } }
        __syncthreads();
        st0 = st0 * gC; st1 = st1 * gC;
#pragma unroll
        for (int s = 0; s < 4; ++s) {
            const s16x4 v0 = LDTR(aV4 + 4096 * s), v1 = LDTR((aV4 ^ 16) + 1024 + 4096 * s);
            const bf16x8 vf = {v0[0], v0[1], v0[2], v0[3], v1[0], v1[1], v1[2], v1[3]};
            const s16x4 k0 = LDTR(aK4 + 4096 * s), k1 = LDTR((aK4 ^ 16) + 1024 + 4096 * s), k2 = LDTR((aK4 ^ 64) + 4096 * s), k3 = LDTR((aK4 ^ 64 ^ 16) + 1024 + 4096 * s);
            const bf16x8 kf0 = {k0[0], k0[1], k0[2], k0[3], k1[0], k1[1], k1[2], k1[3]}, kf1 = {k2[0], k2[1], k2[2], k2[3], k3[0], k3[1], k3[2], k3[3]};
            st0 = __builtin_amdgcn_mfma_f32_32x32x16_bf16(kf0, vf, st0, 0, 0, 0); st1 = __builtin_amdgcn_mfma_f32_32x32x16_bf16(kf1, vf, st1, 0, 0, 0); }
#pragma unroll
        for (int g = 0; g < 4; ++g) { u32x2 w0, w1; w0.x = pk2(st0[4 * g], st0[4 * g + 1]); w0.y = pk2(st0[4 * g + 2], st0[4 * g + 3]); w1.x = pk2(st1[4 * g], st1[4 * g + 1]); w1.y = pk2(st1[4 * g + 2], st1[4 * g + 3]);
            *(LAS u32x2*)(uintptr_t)(aW ^ (16 * g)) = w0; *(LAS u32x2*)(uintptr_t)(aW ^ 64 ^ (16 * g)) = w1; }
#pragma unroll
        for (int i = 0; i < 16; ++i) { const int cl = (i & 3) + 8 * (i >> 2);
            const f32x4 a1 = *(const LAS f32x4*)(uintptr_t)(aR + 16 * cl), a2 = *(const LAS f32x4*)(uintptr_t)(aR + 1024 + 16 * cl);
            const float mean = ((a1.x + a1.y) + (a1.z + a1.w)) * (1.f / 128.f), var = fmaxf(((a2.x + a2.y) + (a2.z + a2.w)) * (1.f / 128.f) - mean * mean, 0.f), rstd = 1.f / sqrtf(var + LN_EPS);
            const float g = bf1(*(const LAS bf16*)(uintptr_t)(aG + 256 * cl));
            const size_t t = (size_t)b * SEQ + n * CHUNK + 32 * cb + 4 * hh + cl;
            YR[t * RET_W + h * RET_HD + 32 * eb + r] = (bf16)f2bf((yi[i] - mean) * rstd * gnw * (g * sigm(g))); }
    }
#undef LD128
#undef LDTR
#undef ST128
#undef RET_LOAD
#undef RET_LOAD2
    __syncthreads();
}

__device__ __forceinline__ void rwkv_scan(Frame& F) {
    if (F.wave >= 4) return;
    const int lane = F.lane, W = F.vcu * 4 + F.wave, bh = W >> 4, rg = W & 15, j = lane & 15, row = 4 * rg + (lane >> 4);
    const bf16* sp = (const bf16*)(F.ws + WS_SI) + (size_t)bh * SEQ * 384;
    float* yraw = (float*)(F.ws + WS_YRAW) + (size_t)(bh >> 3) * SEQ * RW_W + (bh & 7) * RW_HD + row;
    float s0 = 0.f, s1 = 0.f, s2 = 0.f, s3 = 0.f;
    u32x2 cr[4], ck[4], ckk[4], cnb[4], com[4]; bf16 cv[4];
    u32x2 nr[4], nk[4], nkk[4], nnb[4], nom[4]; bf16 nv[4];
#define SCAN_LOAD(R, K, KK, NB, OM, V, t0) do { _Pragma("unroll") for (int u = 0; u < 4; ++u) { const bf16* p = sp + (size_t)((t0) + u) * 384; \
        R[u] = *(const u32x2*)(p + 4 * j); K[u] = *(const u32x2*)(p + 64 + 4 * j); KK[u] = *(const u32x2*)(p + 128 + 4 * j); NB[u] = *(const u32x2*)(p + 192 + 4 * j); OM[u] = *(const u32x2*)(p + 256 + 4 * j); V[u] = p[320 + row]; } } while (0)
    SCAN_LOAD(cr, ck, ckk, cnb, com, cv, 0);
    for (int tb = 0; tb < SEQ; tb += 4) {
        const int tn = (tb + 4 < SEQ) ? tb + 4 : tb;
        SCAN_LOAD(nr, nk, nkk, nnb, nom, nv, tn);
#pragma unroll
        for (int u = 0; u < 4; ++u) {
            const float vv = bf1(cv[u]);
            float dot = s0 * bfl(ckk[u].x) + s1 * bfh(ckk[u].x) + s2 * bfl(ckk[u].y) + s3 * bfh(ckk[u].y);
            dot = row_sum16(dot);
            s0 = s0 * (1.f - bfl(com[u].x)) + dot * bfl(cnb[u].x) + vv * bfl(ck[u].x);
            s1 = s1 * (1.f - bfh(com[u].x)) + dot * bfh(cnb[u].x) + vv * bfh(ck[u].x);
            s2 = s2 * (1.f - bfl(com[u].y)) + dot * bfl(cnb[u].y) + vv * bfl(ck[u].y);
            s3 = s3 * (1.f - bfh(com[u].y)) + dot * bfh(cnb[u].y) + vv * bfh(ck[u].y);
            float y = s0 * bfl(cr[u].x) + s1 * bfh(cr[u].x) + s2 * bfl(cr[u].y) + s3 * bfh(cr[u].y);
            y = row_sum16(y);
            if (j == 0) yraw[(size_t)(tb + u) * RW_W] = y;
        }
#pragma unroll
        for (int u = 0; u < 4; ++u) { cr[u] = nr[u]; ck[u] = nk[u]; ckk[u] = nkk[u]; cnb[u] = nnb[u]; com[u] = nom[u]; cv[u] = nv[u]; }
    }
#undef SCAN_LOAD
}
__device__ __forceinline__ void rwkv_finish(KArgs A, Frame& F, int l) {
    const int gw = F.vcu * NWAVES + F.wave, NGW = F.G * NWAVES, lane = F.lane, h = lane >> 3, c0 = 8 * lane;
    const float* yraw = (const float*)(F.ws + WS_YRAW); const bf16* SI = (const bf16*)(F.ws + WS_SI); const bf16* Gb = (const bf16*)(F.ws + WS_G); const float* RB = (const float*)(F.ws + WS_RB);
    bf16* YY = (bf16*)(F.ws + WS_YK);
    const float* lng = IN(17) + (size_t)l * RW_W + c0; const float* lnb = IN(18) + (size_t)l * RW_W + c0;
    const f32x4 g0 = *(const f32x4*)lng, g1 = *(const f32x4*)(lng + 4), b0 = *(const f32x4*)lnb, b1 = *(const f32x4*)(lnb + 4);
    const float gv[8] = {g0.x, g0.y, g0.z, g0.w, g1.x, g1.y, g1.z, g1.w}, bv[8] = {b0.x, b0.y, b0.z, b0.w, b1.x, b1.y, b1.z, b1.w};
    for (int t = gw; t < T; t += NGW) {
        const f32x4 y0 = *(const f32x4*)(yraw + (size_t)t * RW_W + c0), y1 = *(const f32x4*)(yraw + (size_t)t * RW_W + c0 + 4);
        float y[8] = {y0.x, y0.y, y0.z, y0.w, y1.x, y1.y, y1.z, y1.w};
        float s = 0.f;
#pragma unroll
        for (int i = 0; i < 8; ++i) s += y[i];
        const float mean = row_sum8(s) * (1.f / 64.f); float q = 0.f;
#pragma unroll
        for (int i = 0; i < 8; ++i) { y[i] -= mean; q += y[i] * y[i]; }
        const float rstd = 1.f / sqrtf(row_sum8(q) * (1.f / 64.f) + RW_GN_EPS);
        const int b = t >> 11, sq = t & (SEQ - 1);
        const v4u vv = *(const v4u*)(SI + ((size_t)(b * RW_H + h) * SEQ + sq) * 384 + 320 + (c0 & 63));
        const v4u gg = *(const v4u*)(Gb + (size_t)t * RW_W + c0);
        const float bon = RB[(size_t)t * 8 + h];
        const unsigned vw[4] = {vv.x, vv.y, vv.z, vv.w}, gwv[4] = {gg.x, gg.y, gg.z, gg.w}; unsigned o[4];
#pragma unroll
        for (int i = 0; i < 4; ++i) {
            const float a0 = (y[2 * i] * rstd * gv[2 * i] + bv[2 * i] + bon * bfl(vw[i])) * bfl(gwv[i]);
            const float a1 = (y[2 * i + 1] * rstd * gv[2 * i + 1] + bv[2 * i + 1] + bon * bfh(vw[i])) * bfh(gwv[i]);
            o[i] = pk2(a0, a1);
        }
        *(v4u*)(YY + (size_t)t * RW_W + c0) = (v4u){o[0], o[1], o[2], o[3]};
    }
}
template <bool ROUTE> __device__ __forceinline__ void ln_phase(KArgs A, Frame& F, int l, const float* g, const float* b) {
    const int gw = F.vcu * NWAVES + F.wave, NGW = F.G * NWAVES, lane = F.lane;
    const float* H1 = (const float*)(F.ws + WS_H1); bf16* XN = (bf16*)(F.ws + WS_XN);
    const float* rw = IN(4); const float* rbias = IN(5);
    int* lists = (int*)(F.ws + WS_LISTS); int* tokinfo = (int*)(F.ws + WS_TOKINFO);
    for (int m = gw; m < T; m += NGW) {
        float* xr = F.X + (size_t)m * D; const float* hr = H1 + (size_t)m * D; f32x4 v[4];
#pragma unroll
        for (int j = 0; j < 4; ++j) v[j] = *(const f32x4*)(xr + 4 * lane + 256 * j) * ALPHA + *(const f32x4*)(hr + 4 * lane + 256 * j);
        ln_store(v, g, b, xr, XN + (size_t)m * D, lane);
        if (ROUTE) {
            float lg[16];
#pragma unroll
            for (int e = 0; e < 16; ++e) lg[e] = 0.f;
#pragma unroll
            for (int j = 0; j < 4; ++j)
#pragma unroll
                for (int q = 0; q < 4; ++q) { const float xv = v[j][q]; const float* wr_ = rw + (size_t)(4 * lane + 256 * j + q) * NE;
                    const f32x4 w0 = *(const f32x4*)wr_, w1 = *(const f32x4*)(wr_ + 4), w2 = *(const f32x4*)(wr_ + 8), w3 = *(const f32x4*)(wr_ + 12);
                    lg[0] += xv * w0.x; lg[1] += xv * w0.y; lg[2] += xv * w0.z; lg[3] += xv * w0.w; lg[4] += xv * w1.x; lg[5] += xv * w1.y; lg[6] += xv * w1.z; lg[7] += xv * w1.w;
                    lg[8] += xv * w2.x; lg[9] += xv * w2.y; lg[10] += xv * w2.z; lg[11] += xv * w2.w; lg[12] += xv * w3.x; lg[13] += xv * w3.y; lg[14] += xv * w3.z; lg[15] += xv * w3.w; }
            float aff[16], ch[16];
#pragma unroll
            for (int e = 0; e < 16; ++e) { lg[e] = wave_sum(lg[e]); aff[e] = 1.f / (1.f + expf(-lg[e])); ch[e] = aff[e] + rbias[e]; }
            float gs[4];
#pragma unroll
            for (int q = 0; q < 4; ++q) { const float a = ch[4 * q], bb = ch[4 * q + 1], c = ch[4 * q + 2], d = ch[4 * q + 3];
                const float hi1 = fmaxf(a, bb), lo1 = fminf(a, bb), hi2 = fmaxf(c, d), lo2 = fminf(c, d);
                gs[q] = fmaxf(hi1, hi2) + fmaxf(fminf(hi1, hi2), fmaxf(lo1, lo2)); }
            int bg = 0; float best = gs[0];
#pragma unroll
            for (int q = 1; q < 4; ++q) if (gs[q] > best) { best = gs[q]; bg = q; }
            float c4[4], a4[4];
#pragma unroll
            for (int i = 0; i < 4; ++i) { c4[i] = bg == 0 ? ch[i] : bg == 1 ? ch[4 + i] : bg == 2 ? ch[8 + i] : ch[12 + i]; a4[i] = bg == 0 ? aff[i] : bg == 1 ? aff[4 + i] : bg == 2 ? aff[8 + i] : aff[12 + i]; }
            int i1 = 0; float m1 = c4[0];
#pragma unroll
            for (int i = 1; i < 4; ++i) if (c4[i] > m1) { m1 = c4[i]; i1 = i; }
            int i2 = -1; float m2 = 0.f;
#pragma unroll
            for (int i = 0; i < 4; ++i) if (i != i1 && (i2 < 0 || c4[i] > m2)) { m2 = c4[i]; i2 = i; }
            const float af1 = i1 == 0 ? a4[0] : i1 == 1 ? a4[1] : i1 == 2 ? a4[2] : a4[3], af2 = i2 == 0 ? a4[0] : i2 == 1 ? a4[1] : i2 == 2 ? a4[2] : a4[3];
            const float inv = 1.f / (af1 + af2);
            if (lane == 0) {
                const int e1 = 4 * bg + i1, e2 = 4 * bg + i2;
                const int p1 = (int)__hip_atomic_fetch_add(F.ctl + CW_CNT + l * 1024 + 64 * e1, 1u, RLX_AGENT);
                const int p2 = (int)__hip_atomic_fetch_add(F.ctl + CW_CNT + l * 1024 + 64 * e2, 1u, RLX_AGENT);
                lists[e1 * T + p1] = m; lists[e2 * T + p2] = m;
                int* ti = tokinfo + (size_t)m * 8;
                ti[0] = e1; ti[1] = p1; ti[2] = __float_as_int(af1 * inv); ti[3] = e2; ti[4] = p2; ti[5] = __float_as_int(af2 * inv);
            }
        }
    }
}
__device__ __forceinline__ void moe_prefix(Frame& F, int l) {
    if (F.tid == 0) { int acc = 0;
        for (int e = 0; e < NE; ++e) { F.MISC[32 + e] = (unsigned)acc; const unsigned c = __hip_atomic_load(F.ctl + CW_CNT + l * 1024 + 64 * e, RLX_AGENT); acc += (int)((c + 255u) >> 8); }
        F.MISC[32 + NE] = (unsigned)acc; }
    __syncthreads();
}
__device__ __forceinline__ void moe_gather(Frame& F, int l) {
    moe_prefix(F, l);
    const int gw = F.vcu * NWAVES + F.wave, NGW = F.G * NWAVES, lane = F.lane;
    const int* lists = (const int*)(F.ws + WS_LISTS); const bf16* XN = (const bf16*)(F.ws + WS_XN); bf16* XG = (bf16*)(F.ws + WS_XG);
    const int nrows = (int)F.MISC[32 + NE] * 256;
    for (int R = gw; R < nrows; R += NGW) {
        const int mt = R >> 8; int e = 0;
#pragma unroll
        for (int q = 1; q < 16; ++q) e += (mt >= (int)F.MISC[32 + q]) ? 1 : 0;
        const int pos = R - (int)F.MISC[32 + e] * 256; const int cnt = (int)__hip_atomic_load(F.ctl + CW_CNT + l * 1024 + 64 * e, RLX_AGENT);
        v4u a = {0u, 0u, 0u, 0u}, b = {0u, 0u, 0u, 0u};
        if (pos < cnt) { const int tok = lists[e * T + pos]; const v4u* src = (const v4u*)(XN + (size_t)tok * D); a = src[lane]; b = src[64 + lane]; }
        v4u* dst = (v4u*)(XG + (size_t)R * D); dst[lane] = a; dst[64 + lane] = b;
    }
}
__device__ __forceinline__ void moe_combine_ln(Frame& F, int l, const float* g, const float* b) {
    moe_prefix(F, l);
    const int gw = F.vcu * NWAVES + F.wave, NGW = F.G * NWAVES, lane = F.lane;
    const int* tokinfo = (const int*)(F.ws + WS_TOKINFO); const bf16* YM = (const bf16*)(F.ws + WS_YM); bf16* XN = (bf16*)(F.ws + WS_XN);
    for (int m = gw; m < T; m += NGW) {
        const int* ti = tokinfo + (size_t)m * 8;
        const int e1 = ti[0], p1 = ti[1], e2 = ti[3], p2 = ti[4]; const float w1 = __int_as_float(ti[2]), w2 = __int_as_float(ti[5]);
        const bf16* y1 = YM + ((size_t)F.MISC[32 + e1] * 256 + p1) * D; const bf16* y2 = YM + ((size_t)F.MISC[32 + e2] * 256 + p2) * D;
        float* xr = F.X + (size_t)m * D; f32x4 v[4];
#pragma unroll
        for (int j = 0; j < 4; ++j) { const u32x2 a = *(const u32x2*)(y1 + 4 * lane + 256 * j), c = *(const u32x2*)(y2 + 4 * lane + 256 * j);
            const f32x4 ya = {bfl(a.x), bfh(a.x), bfl(a.y), bfh(a.y)}, yc = {bfl(c.x), bfh(c.x), bfl(c.y), bfh(c.y)};
            v[j] = *(const f32x4*)(xr + 4 * lane + 256 * j) * ALPHA + ya * w1 + yc * w2; }
        ln_store(v, g, b, xr, XN + (size_t)m * D, lane);
    }
}

__device__ __forceinline__ void attn_phase(Frame& F) {
    typedef float f32x16 __attribute__((ext_vector_type(16))); typedef short s16x4 __attribute__((ext_vector_type(4)));
    const int u = F.vcu, b = u >> 5, h = (u >> 3) & 3, qb = u & 7, lane = F.lane, r = lane & 31, hh = lane >> 5;
    if (u >= BATCH * XA_H * 8) return;
    const size_t q0 = (size_t)b * SEQ + qb * 256 + F.wave * 32;
    const bf16* Qp = (const bf16*)(F.ws + WS_Q) + (q0 + r) * D + h * XA_HD + 8 * hh;
    const bf16* Kp = (const bf16*)(F.ws + WS_MK) + ((size_t)b * MEM_LEN + r) * D + h * XA_HD + 8 * hh;
    const bf16* Vp = (const bf16*)(F.ws + WS_VT) + ((size_t)h * XA_HD + r) * MEMT + b * MEM_LEN + 4 * hh;
    bf16* Op = (bf16*)(F.ws + WS_O) + q0 * D + h * XA_HD + r;
    f32x16 acc[8];
#pragma unroll
    for (int kb = 0; kb < 8; ++kb) {
        f32x16 a = {0.f, 0.f, 0.f, 0.f, 0.f, 0.f, 0.f, 0.f, 0.f, 0.f, 0.f, 0.f, 0.f, 0.f, 0.f, 0.f};
#pragma unroll 4
        for (int s = 0; s < 16; ++s) { const bf16x8 kf = *(const bf16x8*)(Kp + (size_t)kb * 32 * D + 16 * s), qf = *(const bf16x8*)(Qp + 16 * s); a = __builtin_amdgcn_mfma_f32_32x32x16_bf16(kf, qf, a, 0, 0, 0); }
        acc[kb] = a;
    }
    float mx = -INFINITY;
#pragma unroll
    for (int kb = 0; kb < 8; ++kb)
#pragma unroll
        for (int i = 0; i < 16; ++i) mx = fmaxf(mx, acc[kb][i]);
    mx = fmaxf(mx, __shfl_xor(mx, 32));
    float sum = 0.f;
#pragma unroll
    for (int kb = 0; kb < 8; ++kb)
#pragma unroll
        for (int i = 0; i < 16; ++i) { const float p = __builtin_amdgcn_exp2f(acc[kb][i] - mx); acc[kb][i] = p; sum += p; }
    sum += __shfl_xor(sum, 32);
    const float inv = 1.f / sum;
    bf16x8 pf[16];
#pragma unroll
    for (int s = 0; s < 16; ++s) { const int kb = s >> 1, o = 8 * (s & 1); v4u w;
        w.x = pk2(acc[kb][o + 0] * inv, acc[kb][o + 1] * inv); w.y = pk2(acc[kb][o + 2] * inv, acc[kb][o + 3] * inv); w.z = pk2(acc[kb][o + 4] * inv, acc[kb][o + 5] * inv); w.w = pk2(acc[kb][o + 6] * inv, acc[kb][o + 7] * inv);
        pf[s] = __builtin_bit_cast(bf16x8, w); }
#pragma unroll 1
    for (int db = 0; db < 8; ++db) {
        f32x16 o = {0.f, 0.f, 0.f, 0.f, 0.f, 0.f, 0.f, 0.f, 0.f, 0.f, 0.f, 0.f, 0.f, 0.f, 0.f, 0.f};
        const bf16* vp = Vp + (size_t)db * 32 * MEMT;
#pragma unroll
        for (int s = 0; s < 16; ++s) { const s16x4 lo = *(const s16x4*)(vp + 16 * s), hi = *(const s16x4*)(vp + 16 * s + 8);
            const bf16x8 vf = {lo[0], lo[1], lo[2], lo[3], hi[0], hi[1], hi[2], hi[3]};
            o = __builtin_amdgcn_mfma_f32_32x32x16_bf16(pf[s], vf, o, 0, 0, 0); }
#pragma unroll
        for (int i = 0; i < 16; ++i) { const int qr = (i & 3) + 8 * (i >> 2) + 4 * hh; Op[(size_t)qr * D + db * 32] = (bf16)f2bf(o[i]); }
    }
}
#ifndef PHMASK
#define PHMASK 0xFFFFFFFFu
#endif
#define PHON(i) ((PHMASK >> (i)) & 1u)
__global__ void __launch_bounds__(NWAVES * 64, 2) skel_fwd(Args args) {
    extern __shared__ __attribute__((aligned(16))) unsigned char lds[];
    Frame F;
    F.lds = (LAS unsigned char*)lds; F.MISC = (volatile LAS unsigned*)(F.lds + MISC_OFF);
    F.tid = threadIdx.x; F.lane = F.tid & 63; F.wave = __builtin_amdgcn_readfirstlane(F.tid >> 6);
    F.G = gridDim.x; { const int bx = blockIdx.x; F.vcu = (F.G % 8 == 0) ? (bx % 8) * (F.G / 8) + bx / 8 : bx; }
    F.X = args.out; F.ws = args.ws; F.ctl = (gu32*)(args.ws + WS_CTL);
    for (int u = F.tid; u < 128; u += NWAVES * 64) ((LAS unsigned*)(F.lds + MISC_OFF))[u] = 0u;
    __syncthreads();
    XcdBarrier bar; bar.bar = (unsigned*)(F.ctl + CW_BAR); bar.x = 0; bar.st = nullptr;
    const bool multi = (args.ph_hi - args.ph_lo) > 1;
    if (multi) bar = xcd_barrier_post((unsigned*)(F.ctl + CW_BAR), F.MISC + 8);
    unsigned char* ws = args.ws;
    LAS unsigned char* ring = F.lds;
    typedef pg8::bf16_t bt; typedef const pg8::bf16_t cbt;
#ifndef PROBE_K
#define PROBE_K -100
#define PROBE_N 0
#endif
    for (int ph = args.ph_lo, rep = 0; ph < args.ph_hi; ) {
        const int l = ph == 0 ? 0 : (ph - 1) / 15, k = ph == 0 ? -1 : (ph - 1) % 15;
        int c = (int)blockIdx.x; asm volatile("" : "+s"(c));
        F.vcu = (F.G % 8 == 0) ? (c % 8) * (F.G / 8) + c / 8 : c;
        { int t_ = threadIdx.x; asm volatile("" : "+v"(t_)); F.tid = t_; F.lane = t_ & 63; F.wave = __builtin_amdgcn_readfirstlane(t_ >> 6); }
        KArgs A = (KArgs)__builtin_amdgcn_kernarg_segment_ptr(); asm volatile("" : "+s"(A));
        ws = A->ws; F.ws = ws; F.X = A->out; F.ctl = (gu32*)(ws + WS_CTL);
        switch (k) {
        case -1: if (PHON(0)) p0_prologue(A, F); break;
        case 1: if (PHON(2)) { if (F.vcu < BATCH * RET_H) retention_unit(A, F, l, F.vcu); else rwkv_prep(A, F, l, F.vcu - BATCH * RET_H, F.G - BATCH * RET_H); } break;
        case 2: if (PHON(3)) rwkv_scan(F); break;
        case 6: if (PHON(7)) { ln_phase<false>(A, F, l, IN(22) + (size_t)l * D, IN(23) + (size_t)l * D); convert_wm(A, F, l); } break;
        case 8: if (PHON(9)) attn_phase(F); break;
        case 10: if (PHON(10)) ln_phase<true>(A, F, l, IN(27) + (size_t)l * D, IN(28) + (size_t)l * D); break;
        case 11: if (PHON(11)) moe_gather(F, l); break;
        case 12: case 13: if (PHON(12)) moe_prefix(F, l); break;
        case 14: if (PHON(14)) { moe_combine_ln(F, l, IN(32) + (size_t)l * D, IN(33) + (size_t)l * D); if (l + 1 < DEPTH) convert_wa(A, F, l + 1); } break;
        default: break;
        }
        const int njobs = (k == 0) ? 3 : (k == 4) ? 2 : (k == 3 || k == 5 || k == 7 || k == 9 || k == 12 || k == 13) ? 1 : 0;
        if (PHON(1))
        for (int j = 0; j < njobs; ++j) {
            pg8::Gemm g{nullptr, nullptr, 0, 0, D}; int M = T, N = D, moe = 0;
            pg8::EpiU E{pg8::EM_BF16, nullptr, D, 0xffff, nullptr, 0, 0xffff, 0, 1.f, nullptr, nullptr};
            if (k == 0) {
                if (j == 0) { g.A = (cbt*)(ws + WS_XN); g.Bt = (cbt*)(ws + WS_WIN); N = N1; E.O0 = (bt*)(ws + WS_PRET); E.ld0 = 2048; E.npn0 = 8; E.O1 = (bt*)(ws + WS_PRW); E.ld1 = RW_COLS; }
                else if (j == 1) { g.A = (cbt*)(ws + WS_MEMB); g.Bt = (cbt*)(ws + WS_WKV); M = MEMT; E.O0 = (bt*)(ws + WS_MK); }
                else { g.A = (cbt*)(ws + WS_WKV) + (size_t)D * D; g.Bt = (cbt*)(ws + WS_MEMB); M = D; N = MEMT; E.O0 = (bt*)(ws + WS_VT); E.ld0 = MEMT; }
            } else if (k == 3) { g.A = (cbt*)(ws + WS_XN); g.Bt = (cbt*)(ws + WS_WIN) + (size_t)N1 * D; N = NGATE; E.O0 = (bt*)(ws + WS_PGATE); E.ld0 = NGATE; E.act = 1; }
            else if (k == 4) { g.K = RET_W; E.G = (cbt*)(ws + WS_PGATE); E.F = (float*)(ws + WS_M1); E.O0 = (bt*)(ws + WS_MRG);
                if (j == 0) { g.A = (cbt*)(ws + WS_YR); g.Bt = (cbt*)(ws + WS_WRU); E.mode = pg8::EM_MERGE0; } else { g.A = (cbt*)(ws + WS_YK); g.Bt = (cbt*)(ws + WS_WKU); E.mode = pg8::EM_MERGE1; } }
            else if (k == 5) { g.A = (cbt*)(ws + WS_MRG); g.Bt = (cbt*)(ws + WS_WOUT); E.mode = pg8::EM_F32; E.F = (float*)(ws + WS_H1); }
            else if (k == 7) { g.A = (cbt*)(ws + WS_XN); g.Bt = (cbt*)(ws + WS_WQ); E.O0 = (bt*)(ws + WS_Q); E.scale = 0.0625f * 1.44269504f; }
            else if (k == 9) { g.A = (cbt*)(ws + WS_O); g.Bt = (cbt*)(ws + WS_WO); E.mode = pg8::EM_F32; E.F = (float*)(ws + WS_H1); }
            else if (k == 12) { g.A = (cbt*)(ws + WS_XG); g.Bt = (cbt*)(ws + WS_WMA); moe = 1; E.mode = pg8::EM_MOEA; E.O0 = (bt*)(ws + WS_HM); }
            else { g.A = (cbt*)(ws + WS_HM); g.Bt = (cbt*)(ws + WS_WMB); g.K = DE; moe = 1; E.O0 = (bt*)(ws + WS_YM); E.pn_mask = 3; }
            pg8::OrderU S; S.st.init(M, N, F.G, c); S.moe = moe; S.tp = (const LAS int*)(F.lds + MISC_OFF + 128);
            pg8::gemm_phase<pg8::EpiU, pg8::OrderU, true, true>(ring, g, S, E);
        }
        if (k == 3 && PHON(4)) rwkv_finish(A, F, l);
        if (ph + 1 < args.ph_hi) xcd_barrier(bar);
        if (k == PROBE_K && rep < PROBE_N) ++rep; else { rep = 0; ++ph; }
    }
}

extern "C" void kernel_launch(void* const* d_in, const int* in_sizes, int n_in, void* d_out, int out_size, void* d_ws, size_t ws_size, hipStream_t stream) {
    static int grid = 0;
    if (grid == 0) {
        if (n_in != 34 || in_sizes[0] != T * D || out_size != T * D || ws_size < WS_END) { fprintf(stderr, "kernel_launch: unexpected problem shape (n_in %d, in0 %d, out %d, ws %zu, need %zu)\n", n_in, n_in > 0 ? in_sizes[0] : -1, out_size, ws_size, (size_t)WS_END); grid = -1; return; }
        int dev = 0, cus = 0;
        if (hipGetDevice(&dev) != hipSuccess || hipDeviceGetAttribute(&cus, hipDeviceAttributeMultiprocessorCount, dev) != hipSuccess) { grid = -1; return; }
        if (hipFuncSetAttribute((const void*)skel_fwd, hipFuncAttributeMaxDynamicSharedMemorySize, LDS_BYTES) != hipSuccess) { fprintf(stderr, "kernel_launch: hipFuncSetAttribute failed\n"); grid = -1; return; }
        int per_cu = 0;
        if (hipOccupancyMaxActiveBlocksPerMultiprocessor(&per_cu, (const void*)skel_fwd, NWAVES * 64, LDS_BYTES) != hipSuccess || per_cu < 1) fprintf(stderr, "kernel_launch: occupancy query reports %d\n", per_cu);
        (void)hipGetLastError();
        grid = cus;
        if (grid != 256) fprintf(stderr, "kernel_launch: %d CUs (built for 256)\n", grid);
    }
    if (grid < 0) return;
    (void)hipMemsetAsync((char*)d_ws + WS_CTL, 0, CTL_ZERO_BYTES, stream);
    Args a{};
    for (int i = 0; i < 34; ++i) a.in[i] = (const float*)d_in[i];
    a.out = (float*)d_out; a.ws = (unsigned char*)d_ws;
#if MK_ONE_LAUNCH
    a.ph_lo = 0; a.ph_hi = N_PHASES;
    hipLaunchKernelGGL(skel_fwd, dim3(grid), dim3(NWAVES * 64), LDS_BYTES, stream, a);
#else
    for (int ph = 0; ph < N_PHASES; ++ph) { a.ph_lo = ph; a.ph_hi = ph + 1; hipLaunchKernelGGL(skel_fwd, dim3(grid), dim3(NWAVES * 64), LDS_BYTES, stream, a); }
#endif
}
```

```cpp
#include <hip/hip_runtime.h>
#include <cstdio>
#include <cstdint>
namespace pg8 {
#define PG8_LAS __attribute__((address_space(3)))
typedef unsigned short bf16_t;
typedef short bf16x8 __attribute__((ext_vector_type(8)));
typedef float f32x4 __attribute__((ext_vector_type(4)));
typedef unsigned u32x4 __attribute__((ext_vector_type(4)));
constexpr int BM = 256, BK = 64, HALF = 128, HTB = HALF * BK * 2  , STAGE_BYTES = 8 * HTB, NXCD = 8, WGM = 8;

__host__ __device__ __forceinline__ int lds_byte(int r, int c) { const int st = (r >> 4) * 2 + (c >> 5), rr = r & 15, cc = c & 31, ob = rr * 64 + cc * 2; return st * 1024 + (ob ^ (((ob >> 9) & 1) << 5)); }
__host__ __device__ __forceinline__ void stage_rc(int b, int& R, int& C) { const int st = b / 1024, sb = b % 1024, swz = sb ^ (((sb >> 9) & 1) << 5); R = (st >> 1) * 16 + swz / 64; C = (st & 1) * 32 + (swz % 64) / 2; }
__host__ __device__ __forceinline__ int perm32(int rho) { const int n = rho >> 4, i = rho & 15; return 8 * (i >> 2) + 4 * n + (i & 3); }

struct Unit { int pm, pn; };
struct Gemm { const bf16_t* A; const bf16_t* Bt; int M, N, K; };

struct StaticOrder {
    int nM, nN, nwg, G, c;
    __host__ __device__ void init(int M, int N, int G_, int c_) { nM = M / BM; nN = N / BM; nwg = nM * nN; G = G_; c = c_; }
    __host__ __device__ bool next(int i, Unit& u) const {
        const long L = (long)i * G + c; if (L >= nwg) return false;
        int wgid = (int)L; { const int q = nwg / NXCD, r = nwg % NXCD, xcd = wgid % NXCD, off = wgid / NXCD; wgid = (xcd < r ? xcd * (q + 1) : r * (q + 1) + (xcd - r) * q) + off; }
        const int nig = WGM * nN, gid = wgid / nig, fm = gid * WGM, gsz = (nM - fm) < WGM ? (nM - fm) : WGM;
        u.pm = fm + ((wgid % nig) % gsz); u.pn = (wgid % nig) / gsz; return true;
    }
    __device__ __forceinline__ void a_ready(const Unit&) const {}
    __device__ __forceinline__ void done(const Unit&) const {}
};

__device__ __forceinline__ unsigned cvt_pk_bf16(float lo, float hi) { unsigned r; asm volatile("v_cvt_pk_bf16_f32 %0, %1, %2" : "=v"(r) : "v"(lo), "v"(hi)); return r; }
typedef float f32x2 __attribute__((ext_vector_type(2)));
__device__ __forceinline__ f32x2 gelu_pk(f32x2 v) {
    const f32x2 av = __builtin_elementwise_abs(v), d = av * 0.2316418882f + 1.0f;
    f32x2 t; t.x = __builtin_amdgcn_rcpf(d.x); t.y = __builtin_amdgcn_rcpf(d.y);
    f32x2 q = t * 0.5307027145f + (-0.7265760135f); q = q * t + 0.7107068705f; q = q * t + (-0.142248368f); q = q * t + 0.127414796f; q = q * t;
    const f32x2 s = (v * v) * (-0.72134752044f);
    f32x2 e; e.x = __builtin_amdgcn_exp2f(s.x); e.y = __builtin_amdgcn_exp2f(s.y);
    const f32x2 m = v * (q * e), r = v - m;
    f32x2 o; o.x = v.x < 0.f ? m.x : r.x; o.y = v.y < 0.f ? m.y : r.y; return o;
}

template <int ACT  > struct EpiBf16 {
    static constexpr bool PERM = true, AFTER_DRAIN = false; static_assert(ACT == 0 || ACT == 1, "EpiBf16: ACT is 0 (none) or 1 (gelu_pk)");
    bf16_t* O; int ldc; const float* bias; int split_cols; size_t split_stride; float scale0;
    __device__ __forceinline__ void operator()(const f32x4 (&acc)[2][2][4][2], const Unit& u, int wr, int wc, int fr, int fq) const {
        const int row0 = u.pm * BM + wr * 64 + fr; int colt = u.pn * BM; bf16_t* base = O;
        float sc = 1.f; if (split_cols) { const int t = colt / split_cols; base += (size_t)t * split_stride; colt -= t * split_cols; if (t == 0) sc = scale0; }
        const int col0 = colt + wc * 32 + 8 * fq, bcol0 = u.pn * BM + wc * 32 + 8 * fq;
        f32x4 bv[2][2];
#pragma unroll
        for (int bj = 0; bj < 2; ++bj)
#pragma unroll
            for (int n = 0; n < 2; ++n) bv[bj][n] = bias ? *(const f32x4*)(bias + bcol0 + bj * HALF + 4 * n) : (f32x4){0.f, 0.f, 0.f, 0.f};
#pragma unroll
        for (int ai = 0; ai < 2; ++ai)
#pragma unroll
            for (int m = 0; m < 4; ++m) { bf16_t* rowp = base + (size_t)(row0 + ai * HALF + m * 16) * ldc + col0;
#pragma unroll
                for (int bj = 0; bj < 2; ++bj) { f32x4 v0 = acc[ai][bj][m][0] + bv[bj][0], v1 = acc[ai][bj][m][1] + bv[bj][1];
                    if (ACT == 1) { f32x2 a = gelu_pk((f32x2){v0[0], v0[1]}), b = gelu_pk((f32x2){v0[2], v0[3]}), c = gelu_pk((f32x2){v1[0], v1[1]}), d = gelu_pk((f32x2){v1[2], v1[3]});
                        v0 = (f32x4){a.x, a.y, b.x, b.y}; v1 = (f32x4){c.x, c.y, d.x, d.y}; }
                    v0 = v0 * sc; v1 = v1 * sc; u32x4 w; w.x = cvt_pk_bf16(v0[0], v0[1]); w.y = cvt_pk_bf16(v0[2], v0[3]); w.z = cvt_pk_bf16(v1[0], v1[1]); w.w = cvt_pk_bf16(v1[2], v1[3]);
                    *(u32x4*)(rowp + bj * HALF) = w; } }
    }
};
__device__ __forceinline__ float sigmoid_f(float x) { return __builtin_amdgcn_rcpf(1.f + __builtin_amdgcn_exp2f(-1.44269504f * x)); }
__device__ __forceinline__ float bf_lo(unsigned w) { return __uint_as_float(w << 16); }
__device__ __forceinline__ float bf_hi(unsigned w) { return __uint_as_float(w & 0xffff0000u); }
typedef unsigned u32x2 __attribute__((ext_vector_type(2)));
enum { EM_BF16 = 0, EM_F32 = 1, EM_MERGE0 = 2, EM_MERGE1 = 3, EM_MOEA = 4 };
struct EpiU {
    static constexpr bool PERM = true, AFTER_DRAIN = false;
    int mode; bf16_t* O0; int ld0; int npn0; bf16_t* O1; int ld1; int pn_mask; int act; float scale; float* F; const bf16_t* G;
    __device__ __forceinline__ void operator()(const f32x4 (&acc)[2][2][4][2], const Unit& u, int wr, int wc, int fr, int fq) const {
        const int row0 = u.pm * BM + wr * 64 + fr;
        if (mode == EM_BF16) {
            int pn = u.pn & pn_mask; bf16_t* base = O0; int ldc = ld0; if (pn >= npn0) { pn -= npn0; base = O1; ldc = ld1; }
            const int col0 = pn * BM + wc * 32 + 8 * fq;
#pragma unroll
            for (int ai = 0; ai < 2; ++ai)
#pragma unroll
                for (int m = 0; m < 4; ++m) { bf16_t* rowp = base + (size_t)(row0 + ai * HALF + m * 16) * ldc + col0;
#pragma unroll
                    for (int bj = 0; bj < 2; ++bj) { f32x4 v0 = acc[ai][bj][m][0], v1 = acc[ai][bj][m][1];
                        if (act == 1) {
#pragma unroll
                            for (int q = 0; q < 4; ++q) { v0[q] = sigmoid_f(v0[q]); v1[q] = sigmoid_f(v1[q]); } }
                        v0 = v0 * scale; v1 = v1 * scale; u32x4 w; w.x = cvt_pk_bf16(v0[0], v0[1]); w.y = cvt_pk_bf16(v0[2], v0[3]); w.z = cvt_pk_bf16(v1[0], v1[1]); w.w = cvt_pk_bf16(v1[2], v1[3]);
                        *(u32x4*)(rowp + bj * HALF) = w; } }
        } else if (mode == EM_MOEA) {
            const int col0 = (u.pn & 3) * HALF + wc * 32 + 8 * fq;
#pragma unroll
            for (int ai = 0; ai < 2; ++ai)
#pragma unroll
                for (int m = 0; m < 4; ++m) { bf16_t* rowp = O0 + (size_t)(row0 + ai * HALF + m * 16) * 512 + col0;
                    f32x4 h0, h1;
#pragma unroll
                    for (int q = 0; q < 4; ++q) { const float g0 = acc[ai][0][m][0][q], g1 = acc[ai][0][m][1][q]; h0[q] = g0 * sigmoid_f(g0) * acc[ai][1][m][0][q]; h1[q] = g1 * sigmoid_f(g1) * acc[ai][1][m][1][q]; }
                    u32x4 w; w.x = cvt_pk_bf16(h0[0], h0[1]); w.y = cvt_pk_bf16(h0[2], h0[3]); w.z = cvt_pk_bf16(h1[0], h1[1]); w.w = cvt_pk_bf16(h1[2], h1[3]);
                    *(u32x4*)rowp = w; }
        } else {
            const int col0 = u.pn * BM + wc * 32 + 8 * fq;
#pragma unroll
            for (int ai = 0; ai < 2; ++ai)
#pragma unroll
                for (int m = 0; m < 4; ++m) { const size_t row = (size_t)(row0 + ai * HALF + m * 16);
#pragma unroll
                    for (int bj = 0; bj < 2; ++bj) { const int c = col0 + bj * HALF; f32x4 v0 = acc[ai][bj][m][0], v1 = acc[ai][bj][m][1];
                        if (mode != EM_F32) { const u32x4 gv = *(const u32x4*)(G + row * 2048 + (mode == EM_MERGE1 ? 1024 : 0) + c);
                            v0 = v0 * (f32x4){bf_lo(gv.x), bf_hi(gv.x), bf_lo(gv.y), bf_hi(gv.y)}; v1 = v1 * (f32x4){bf_lo(gv.z), bf_hi(gv.z), bf_lo(gv.w), bf_hi(gv.w)}; }
                        if (mode == EM_MERGE1) { v0 = v0 + *(const f32x4*)(F + row * 1024 + c); v1 = v1 + *(const f32x4*)(F + row * 1024 + c + 4);
                            u32x4 w; w.x = cvt_pk_bf16(v0[0], v0[1]); w.y = cvt_pk_bf16(v0[2], v0[3]); w.z = cvt_pk_bf16(v1[0], v1[1]); w.w = cvt_pk_bf16(v1[2], v1[3]); *(u32x4*)(O0 + row * 1024 + c) = w; }
                        else { *(f32x4*)(F + row * 1024 + c) = v0; *(f32x4*)(F + row * 1024 + c + 4) = v1; } } }
        }
    }
};
struct OrderU {
    StaticOrder st; int moe; const PG8_LAS int* tp;
    __device__ __forceinline__ bool next(int i, Unit& u) const {
        if (!moe) return st.next(i, u);
        const int L = i * st.G + st.c, tot = tp[16] * 4; if (L >= tot) return false;
        const int mt = L >> 2, nt = L & 3; int e = 0;
#pragma unroll
        for (int q = 1; q < 16; ++q) e += (mt >= tp[q]) ? 1 : 0;
        u.pm = mt; u.pn = e * 4 + nt; return true;
    }
    __device__ __forceinline__ void a_ready(const Unit&) const {}
    __device__ __forceinline__ void done(const Unit&) const {}
};
template <class Epi, class Sched, bool ALIGN_EPI = false, bool SP2 = false>
__device__ __forceinline__ void gemm_phase(PG8_LAS unsigned char* lds, const Gemm g, const Sched& S, const Epi& E) {
    const int tid = threadIdx.x, wid = __builtin_amdgcn_readfirstlane(tid >> 6), lane = tid & 63, wr = wid >> 2, wc = wid & 3, fr = lane & 15, fq = lane >> 4;
    const int K = g.K, nt = K / BK;
    unsigned voffA[2], voffB[2];
#pragma unroll
    for (int i = 0; i < 2; ++i) { int R, C; stage_rc(tid * 16 + i * 8192, R, C); const int Rb = Epi::PERM ? ((R & ~31) + perm32(R & 31)) : R;
        voffA[i] = (unsigned)(R * K + C) * 2u; voffB[i] = (unsigned)(Rb * K + C) * 2u; }
    const size_t kstep = (size_t)(BK * 2);
    const size_t hstep = (size_t)HALF * K * 2;
    const size_t tstep = 2 * hstep;
    const unsigned ldsw = (unsigned)wid * 1024u;
    const int aoff = lds_byte(wr * 64 + fr, fq * 8), boff = lds_byte(wc * 32 + fr, fq * 8);
#define PG8_SA(b, h) (((b) * 2 + (h)) * HTB)
#define PG8_SB(b, h) ((4 + (b) * 2 + (h)) * HTB)
#define PG8_STAGE(bufoff, gbase, voff) do { _Pragma("unroll") for (int _i = 0; _i < 2; ++_i) \
        __builtin_amdgcn_global_load_lds((const unsigned*)((const char*)(gbase) + (voff)[_i]), (PG8_LAS unsigned*)(lds + (bufoff) + ldsw + _i * 8192), 16, 0, 0); } while (0)
#define PG8_LDA(dst, b, h) do { _Pragma("unroll") for (int m = 0; m < 4; ++m) _Pragma("unroll") for (int k = 0; k < 2; ++k) dst[m][k] = *(const PG8_LAS bf16x8*)(lds + PG8_SA(b, h) + aoff + m * 2048 + k * 1024); } while (0)
#define PG8_LDB(dst, b, h) do { _Pragma("unroll") for (int n = 0; n < 2; ++n) _Pragma("unroll") for (int k = 0; k < 2; ++k) dst[n][k] = *(const PG8_LAS bf16x8*)(lds + PG8_SB(b, h) + boff + n * 2048 + k * 1024); } while (0)
#define PG8_MMA(ai, bj, At, Bt) do { __builtin_amdgcn_s_setprio(1); _Pragma("unroll") for (int m = 0; m < 4; ++m) _Pragma("unroll") for (int n = 0; n < 2; ++n) _Pragma("unroll") for (int k = 0; k < 2; ++k) \
        acc[ai][bj][m][n] = __builtin_amdgcn_mfma_f32_16x16x32_bf16(Bt[n][k], At[m][k], acc[ai][bj][m][n], 0, 0, 0); __builtin_amdgcn_s_setprio(0); } while (0)
#define PG8_WAIT_V(n) asm volatile("s_waitcnt vmcnt(" #n ")" ::: "memory")
#define PG8_WAIT_L(n) asm volatile("s_waitcnt lgkmcnt(" #n ")" ::: "memory")
#define PG8_BAR __builtin_amdgcn_s_barrier()
#define PG8_SCHED __builtin_amdgcn_sched_barrier(0)
    Unit cur, nxt; int ui = 0;
    if (!S.next(0, cur)) return;
    f32x4 acc[2][2][4][2];
#pragma unroll
    for (int a = 0; a < 2; ++a)
#pragma unroll
        for (int b = 0; b < 2; ++b)
#pragma unroll
            for (int m = 0; m < 4; ++m)
#pragma unroll
                for (int n = 0; n < 2; ++n) acc[a][b][m][n] = (f32x4){0.f, 0.f, 0.f, 0.f};
    bf16x8 At[4][2], B0[2][2], B1[2][2];
    const char* cA = (const char*)g.A + (size_t)cur.pm * tstep; const char* cB = (const char*)g.Bt + (size_t)cur.pn * tstep;
    S.a_ready(cur);
    if constexpr (SP2) {
        PG8_STAGE(PG8_SB(0, 0), cB, voffB); PG8_STAGE(PG8_SB(0, 1), cB + hstep, voffB); PG8_STAGE(PG8_SA(0, 0), cA, voffA); PG8_STAGE(PG8_SA(0, 1), cA + hstep, voffA);
        if (wr == 1) PG8_BAR;
        PG8_WAIT_V(2); PG8_BAR;
        PG8_STAGE(PG8_SB(1, 0), cB + kstep, voffB); PG8_STAGE(PG8_SA(1, 0), cA + kstep, voffA); PG8_STAGE(PG8_SB(1, 1), cB + hstep + kstep, voffB);
        PG8_WAIT_V(6); PG8_BAR;
    } else {
        PG8_STAGE(PG8_SB(0, 0), cB, voffB); PG8_STAGE(PG8_SA(0, 0), cA, voffA); PG8_STAGE(PG8_SB(0, 1), cB + hstep, voffB); PG8_STAGE(PG8_SA(0, 1), cA + hstep, voffA);
        if (wr == 1) PG8_BAR;
        PG8_WAIT_V(4); PG8_BAR;
        PG8_STAGE(PG8_SB(1, 0), cB + kstep, voffB); PG8_STAGE(PG8_SA(1, 0), cA + kstep, voffA); PG8_STAGE(PG8_SB(1, 1), cB + hstep + kstep, voffB);
        PG8_WAIT_V(6); PG8_BAR;
    }
    for (;;) {
        const bool has_next = S.next(ui + 1, nxt);
        const char* nA = has_next ? (const char*)g.A + (size_t)nxt.pm * tstep : cA; const char* nB = has_next ? (const char*)g.Bt + (size_t)nxt.pn * tstep : cB;
        for (int t = 0; t < nt; t += 2) {
            const bool last = (t == nt - 2);
            const char* a1 = cA + (size_t)(t + 1) * kstep;
            const char* a2 = last ? nA : cA + (size_t)(t + 2) * kstep; const char* b2 = last ? nB : cB + (size_t)(t + 2) * kstep;
            const char* a3 = a2 + kstep; const char* b3 = b2 + kstep;
            if (last && has_next) S.a_ready(nxt);
            if constexpr (SP2) {
            PG8_LDB(B0, 0, 0); PG8_LDB(B1, 0, 1); PG8_SCHED; PG8_LDA(At, 0, 0); PG8_STAGE(PG8_SA(1, 1), a1 + hstep, voffA);
            PG8_WAIT_V(8); PG8_WAIT_L(0); PG8_BAR; PG8_MMA(0, 0, At, B0); PG8_MMA(0, 1, At, B1); PG8_BAR; PG8_SCHED;
            PG8_LDA(At, 0, 1); PG8_STAGE(PG8_SB(0, 0), b2, voffB); PG8_STAGE(PG8_SB(0, 1), b2 + hstep, voffB); PG8_STAGE(PG8_SA(0, 0), a2, voffA);
            PG8_WAIT_V(8); PG8_WAIT_L(0); PG8_BAR; PG8_MMA(1, 0, At, B0); PG8_MMA(1, 1, At, B1); PG8_BAR; PG8_SCHED;
            PG8_LDB(B0, 1, 0); PG8_LDB(B1, 1, 1); PG8_SCHED; PG8_LDA(At, 1, 0); PG8_STAGE(PG8_SA(0, 1), a2 + hstep, voffA);
            PG8_WAIT_V(8); PG8_WAIT_L(0); PG8_BAR; PG8_MMA(0, 0, At, B0); PG8_MMA(0, 1, At, B1); PG8_BAR; PG8_SCHED;
            PG8_LDA(At, 1, 1); PG8_STAGE(PG8_SB(1, 0), b3, voffB); PG8_STAGE(PG8_SB(1, 1), b3 + hstep, voffB); PG8_STAGE(PG8_SA(1, 0), a3, voffA);
            PG8_WAIT_V(8); PG8_WAIT_L(0); PG8_BAR; PG8_MMA(1, 0, At, B0); PG8_MMA(1, 1, At, B1); PG8_BAR; PG8_SCHED;
            } else {
            PG8_LDB(B0, 0, 0); PG8_SCHED; PG8_LDA(At, 0, 0); PG8_STAGE(PG8_SA(1, 1), a1 + hstep, voffA);
            PG8_WAIT_L(8); PG8_BAR; PG8_WAIT_L(0); PG8_MMA(0, 0, At, B0); PG8_BAR; PG8_SCHED;
            PG8_LDB(B1, 0, 1); PG8_STAGE(PG8_SB(0, 0), b2, voffB);
            PG8_BAR; PG8_WAIT_L(0); PG8_MMA(0, 1, At, B1); PG8_BAR;
            PG8_LDA(At, 0, 1); PG8_STAGE(PG8_SA(0, 0), a2, voffA);
            PG8_BAR; PG8_WAIT_L(0); PG8_MMA(1, 0, At, B0); PG8_BAR; PG8_SCHED;
            PG8_STAGE(PG8_SB(0, 1), b2 + hstep, voffB);
            PG8_WAIT_V(6); PG8_BAR; PG8_MMA(1, 1, At, B1); PG8_BAR;
            PG8_LDB(B0, 1, 0); PG8_SCHED; PG8_LDA(At, 1, 0); PG8_STAGE(PG8_SA(0, 1), a2 + hstep, voffA);
            PG8_WAIT_L(8); PG8_BAR; PG8_WAIT_L(0); PG8_MMA(0, 0, At, B0); PG8_BAR; PG8_SCHED;
            PG8_LDB(B1, 1, 1); PG8_STAGE(PG8_SB(1, 0), b3, voffB);
            PG8_BAR; PG8_WAIT_L(0); PG8_MMA(0, 1, At, B1); PG8_BAR;
            PG8_LDA(At, 1, 1); PG8_STAGE(PG8_SA(1, 0), a3, voffA);
            PG8_BAR; PG8_WAIT_L(0); PG8_MMA(1, 0, At, B0); PG8_BAR; PG8_SCHED;
            PG8_STAGE(PG8_SB(1, 1), b3 + hstep, voffB);
            PG8_WAIT_V(6); PG8_BAR; PG8_MMA(1, 1, At, B1); PG8_BAR;
            }
        }
        if constexpr (ALIGN_EPI) { if (wr == 0) PG8_BAR; }
        if constexpr (!Epi::AFTER_DRAIN) { E(acc, cur, wr, wc, fr, fq); S.done(cur); }
        if (!has_next) break;
#pragma unroll
        for (int a = 0; a < 2; ++a)
#pragma unroll
            for (int b = 0; b < 2; ++b)
#pragma unroll
                for (int m = 0; m < 4; ++m)
#pragma unroll
                    for (int n = 0; n < 2; ++n) acc[a][b][m][n] = (f32x4){0.f, 0.f, 0.f, 0.f};
        cur = nxt; cA = nA; cB = nB; ++ui;
        if constexpr (ALIGN_EPI) { if (wr == 1) PG8_BAR; }
    }
    PG8_WAIT_V(0);
    if constexpr (!ALIGN_EPI) { if (wr == 0) PG8_BAR; }
    PG8_BAR;
    if constexpr (Epi::AFTER_DRAIN) { E.fused(acc, cur, wr, wc, fr, fq, lds, wid, lane); S.done(cur); }
#undef PG8_SA
#undef PG8_SB
#undef PG8_STAGE
#undef PG8_LDA
#undef PG8_LDB
#undef PG8_MMA
#undef PG8_WAIT_V
#undef PG8_WAIT_L
#undef PG8_BAR
#undef PG8_SCHED
}
}
constexpr int NWAVES = 8;
constexpr int BATCH = 8, SEQ = 2048, T = BATCH * SEQ, D = 1024, DEPTH = 2;
constexpr int RET_H = 4, RET_HD = 128, RET_W = 512, CHUNK = 64, NCHUNK = SEQ / CHUNK;
constexpr int RW_H = 8, RW_HD = 64, RW_W = 512, RW_COLS = 1792;
constexpr int N_IN = 5888, N1 = 3840, NGATE = 2048;
constexpr int MEM_LEN = 256, MEMT = BATCH * MEM_LEN, XA_H = 4, XA_HD = 256;
constexpr int NE = 16, DE = 512;
constexpr float ALPHA = 1.41421356237f;
constexpr float LN_EPS = 1e-5f, RW_GN_EPS = 64e-5f;
constexpr int N_PHASES = 1 + 15 * DEPTH;
#ifndef MK_ONE_LAUNCH
#define MK_ONE_LAUNCH 1
#endif

constexpr size_t MiB = 1u << 20;
constexpr size_t WS_CTL = 0, CTL_ZERO_BYTES = 1 * MiB;
constexpr size_t WS_ROPE = 1 * MiB;
constexpr size_t WS_LISTS = 2 * MiB;
constexpr size_t WS_SC = 2 * MiB;
constexpr size_t WS_TOKINFO = 3 * MiB;
constexpr size_t WS_RB = 3 * MiB + 512 * 1024;
constexpr size_t WS_MEMB = 4 * MiB;
constexpr size_t WS_WIN = 8 * MiB;
constexpr size_t WS_WRU = WS_WIN + (size_t)N_IN * D * 2;
constexpr size_t WS_WKU = WS_WRU + MiB;
constexpr size_t WS_WOUT = WS_WKU + MiB;
constexpr size_t WS_WQ = WS_WOUT + 2 * MiB;
constexpr size_t WS_WKV = WS_WQ + 2 * MiB;
constexpr size_t WS_WO = WS_WKV + 4 * MiB;
constexpr size_t WS_MK = 32 * MiB;
constexpr size_t WS_VT = 36 * MiB;
constexpr size_t WS_XN = 40 * MiB;
constexpr size_t AR = 72 * MiB;
constexpr size_t WS_PRET = AR, WS_PRW = AR + 64 * MiB, WS_SI = AR + 120 * MiB, WS_YR = AR + 216 * MiB, WS_YK = AR + 232 * MiB, WS_G = AR + 248 * MiB;
constexpr size_t WS_YRAW = AR, WS_PGATE = AR + 32 * MiB, WS_MRG = AR + 96 * MiB, WS_M1 = AR + 128 * MiB, WS_H1 = AR;
constexpr size_t WS_WMA = AR + 160 * MiB, WS_WMB = AR + 192 * MiB;
constexpr size_t WS_Q = AR + 64 * MiB, WS_O = AR + 96 * MiB;
constexpr size_t WS_XG = AR, WS_HM = AR + 72 * MiB, WS_YM = AR;
constexpr size_t WS_END = AR + 264 * MiB;
static_assert(WS_WO + 2 * MiB <= WS_MK, "ws map");
constexpr int MOE_MAXROWS = 2 * T + NE * 256;
static_assert((size_t)MOE_MAXROWS * 1024 * 2 <= 72 * MiB && (size_t)MOE_MAXROWS * 512 * 2 <= 36 * MiB, "moe buffers");
constexpr int CW_TMO = 0, CW_CODE = 1, CW_BAR = 4096, CW_CNT = 8192;

constexpr int LDS_BYTES = 163840, MISC_OFF = LDS_BYTES - 512;
#define GAS __attribute__((address_space(1)))
#define LAS __attribute__((address_space(3)))
typedef unsigned short bf16;
typedef unsigned v4u __attribute__((ext_vector_type(4)));
typedef float f32x4 __attribute__((ext_vector_type(4)));
typedef short bf16x8 __attribute__((ext_vector_type(8)));
typedef GAS unsigned gu32;
typedef GAS unsigned long long gu64;
#define RLX_AGENT __ATOMIC_RELAXED, __HIP_MEMORY_SCOPE_AGENT
#define LDS_WAIT() asm volatile("s_waitcnt lgkmcnt(0)" ::: "memory")
#define VM_WAIT() asm volatile("s_waitcnt vmcnt(0)" ::: "memory")
__device__ __forceinline__ unsigned long long rt() { return __builtin_amdgcn_s_memrealtime(); }
__device__ __forceinline__ unsigned f2bf(float f) { unsigned u = __builtin_bit_cast(unsigned, f); return (u + 0x7fffu + ((u >> 16) & 1u)) >> 16; }
__device__ __forceinline__ unsigned pk2(float lo, float hi) { return f2bf(lo) | (f2bf(hi) << 16); }

#define XB_TMO      128
#define XB_XCNT(j)  (256  + 64 * (j))
#define XB_XSUB(j)  (1280 + 64 * (j))
#define XB_XGEN(j)  (2304 + 64 * (j))
#define XB_TOP      3328
#define XB_TOPGEN   3392
#define XCD_BAR_WORDS 3456
#define XB_SPIN_CAP (1u << 18)

__device__ __forceinline__ unsigned xb_ld(unsigned* p)              { return __hip_atomic_load(p, __ATOMIC_RELAXED, __HIP_MEMORY_SCOPE_AGENT); }
__device__ __forceinline__ unsigned xb_add(unsigned* p, unsigned v) { return __hip_atomic_fetch_add(p, v, __ATOMIC_RELAXED, __HIP_MEMORY_SCOPE_AGENT); }
__device__ __forceinline__ unsigned xb_xcc_id() { return (unsigned)__builtin_amdgcn_s_getreg((3 << 11) | 20) & 0xFu; }
#define XB_SPIN(cond, bar) do { unsigned _sp = 0; while (cond) { __builtin_amdgcn_s_sleep(1); \
    if ((++_sp & 255u) == 0u) { if (xb_ld(&(bar)[XB_TMO])) break; if (_sp > XB_SPIN_CAP) { atomicAdd(&(bar)[XB_TMO], 1u); break; } } } } while (0)

struct XcdBarrier {
    unsigned* bar; unsigned x;
    volatile LAS unsigned* st;
};

__device__ __forceinline__ XcdBarrier xcd_barrier_post(unsigned* bar, volatile LAS unsigned* st) {
    XcdBarrier b; b.bar = bar; b.x = xb_xcc_id(); b.st = st;
    if (threadIdx.x == 0) (void)xb_add(&bar[XB_XCNT(b.x)], 1u);
    return b;
}
__device__ __forceinline__ void xcd_barrier_complete(unsigned* bar, unsigned x, unsigned& nloc, unsigned& nx) {
    const unsigned G = gridDim.x * gridDim.y * gridDim.z;
    unsigned sum, cnt, mine, sp = 0u;
    for (;;) {
        sum = 0u; cnt = 0u; mine = 0u;
#pragma unroll
        for (unsigned j = 0; j < 16; ++j) { const unsigned c = xb_ld(&bar[XB_XCNT(j)]); sum += c; cnt += (c > 0u) ? 1u : 0u; mine = (j == x) ? c : mine; }
        if (sum == G) break;
        __builtin_amdgcn_s_sleep(1);
        if ((++sp & 255u) == 0u) { if (xb_ld(&bar[XB_TMO])) break; if (sp > XB_SPIN_CAP) { atomicAdd(&bar[XB_TMO], 1u); break; } }
    }
    nloc = mine > 0u ? mine : 1u; nx = cnt > 0u ? cnt : 1u;
}

__device__ __forceinline__ void xcd_barrier(const XcdBarrier& b) {
    asm volatile("s_waitcnt vmcnt(0)" ::: "memory");
    __syncthreads();
    if (threadIdx.x == 0) {
        unsigned* bar = b.bar;
        __builtin_amdgcn_s_waitcnt(0);
        unsigned nloc = b.st[0], nx = b.st[1];
        if (nloc == 0u) { xcd_barrier_complete(bar, b.x, nloc, nx); b.st[0] = nloc; b.st[1] = nx; }
        const unsigned old = xb_add(&bar[XB_XSUB(b.x)], 1u);
        const unsigned gen = old / nloc;
        if (old + 1u == (gen + 1u) * nloc) {
            __builtin_amdgcn_fence(__ATOMIC_RELEASE, "agent");
            asm volatile("s_waitcnt vmcnt(0)" ::: "memory");
            const unsigned og = xb_add(&bar[XB_TOP], 1u);
            const unsigned tg = og / nx;
            if (og + 1u == (tg + 1u) * nx) xb_add(&bar[XB_TOPGEN], 1u);
            else XB_SPIN(xb_ld(&bar[XB_TOPGEN]) == tg, bar);
            __builtin_amdgcn_fence(__ATOMIC_ACQUIRE, "agent");
            xb_add(&bar[XB_XGEN(b.x)], 1u);
            asm volatile("s_waitcnt vmcnt(0)" ::: "memory");
        } else {
            XB_SPIN(xb_ld(&bar[XB_XGEN(b.x)]) == gen, bar);
            __builtin_amdgcn_fence(__ATOMIC_ACQUIRE, "agent");
            asm volatile("s_waitcnt vmcnt(0)" ::: "memory");
        }
    }
    __syncthreads();
}
typedef unsigned u32x2 __attribute__((ext_vector_type(2)));
typedef float f32x2 __attribute__((ext_vector_type(2)));
struct Args { const float* in[34]; float* out; unsigned char* ws; int ph_lo, ph_hi; };
typedef const __attribute__((address_space(4))) Args* KArgs;
#define IN(i) (A->in[i])
struct Frame {
    LAS unsigned char* lds; volatile LAS unsigned* MISC; gu32* ctl;
    int tid, lane, wave, vcu, G;
    float* X; unsigned char* ws;
};
__device__ __forceinline__ float wave_sum(float v) {
#pragma unroll
    for (int o = 1; o < 64; o <<= 1) v += __shfl_xor(v, o);
    return v;
}
#define DPP_F(x, ctrl) __int_as_float(__builtin_amdgcn_update_dpp(0, __float_as_int(x), (ctrl), 0xF, 0xF, true))
__device__ __forceinline__ float row_sum16(float x) {
    x += DPP_F(x, 0xB1); x += DPP_F(x, 0x4E); x += DPP_F(x, 0x141); x += DPP_F(x, 0x140); return x;
}
__device__ __forceinline__ float row_sum8(float x) {
    x += DPP_F(x, 0xB1); x += DPP_F(x, 0x4E); x += DPP_F(x, 0x141); return x;
}
__device__ __forceinline__ float sigm(float x) { return __builtin_amdgcn_rcpf(1.f + __builtin_amdgcn_exp2f(-1.44269504f * x)); }
__device__ __forceinline__ float bfl(unsigned w) { return __uint_as_float(w << 16); }
__device__ __forceinline__ float bfh(unsigned w) { return __uint_as_float(w & 0xffff0000u); }
__device__ __forceinline__ float bf1(bf16 h) { return __uint_as_float((unsigned)h << 16); }

__device__ __forceinline__ void transpose_block(const float* W, int ldw, int k0, int n0, bf16* WT, int ldt, int drow0, LAS float* scr, int lane) {
#pragma unroll 8
    for (int i = 0; i < 32; ++i) { const int kk = 2 * i + (lane >> 5); scr[kk * 33 + (lane & 31)] = W[(size_t)(k0 + kk) * ldw + n0 + (lane & 31)]; }
    LDS_WAIT(); asm volatile("" ::: "memory");
    const int c = lane & 7;
#pragma unroll
    for (int j = 0; j < 4; ++j) { const int n = (lane >> 3) + 8 * j; const LAS float* s = scr + (8 * c) * 33 + n;
        v4u o; o.x = pk2(s[0 * 33], s[1 * 33]); o.y = pk2(s[2 * 33], s[3 * 33]); o.z = pk2(s[4 * 33], s[5 * 33]); o.w = pk2(s[6 * 33], s[7 * 33]);
        *(GAS v4u*)(WT + (size_t)(drow0 + n) * ldt + k0 + 8 * c) = o; }
    LDS_WAIT(); asm volatile("" ::: "memory");
}
__device__ __forceinline__ void convert_wa(KArgs A, Frame& F, int l) {
    LAS float* scr = (LAS float*)(F.lds + F.wave * 16384);
    const int gw = F.vcu * NWAVES + F.wave, NGW = F.G * NWAVES;
    constexpr int I0 = 16 * 184, I1 = 8 * 32, I3 = 16 * 32, I5 = 16 * 64;
    constexpr int NIT = I0 + 2 * I1 + 3 * I3 + I5;
    for (int it = gw; it < NIT; it += NGW) {
        int r = it; const float* W; int K, N; bf16* dst;
        if (r < I0) { W = IN(6) + (size_t)l * D * N_IN; K = D; N = N_IN; dst = (bf16*)(F.ws + WS_WIN); }
        else if ((r -= I0) < I1) { W = IN(19) + (size_t)l * RET_W * D; K = RET_W; N = D; dst = (bf16*)(F.ws + WS_WRU); }
        else if ((r -= I1) < I1) { W = IN(20) + (size_t)l * RW_W * D; K = RW_W; N = D; dst = (bf16*)(F.ws + WS_WKU); }
        else if ((r -= I1) < I3) { W = IN(21) + (size_t)l * D * D; K = D; N = D; dst = (bf16*)(F.ws + WS_WOUT); }
        else if ((r -= I3) < I3) { W = IN(24) + (size_t)l * D * D; K = D; N = D; dst = (bf16*)(F.ws + WS_WQ); }
        else if ((r -= I3) < I5) { W = IN(25) + (size_t)l * D * 2 * D; K = D; N = 2 * D; dst = (bf16*)(F.ws + WS_WKV); }
        else { r -= I5; W = IN(26) + (size_t)l * D * D; K = D; N = D; dst = (bf16*)(F.ws + WS_WO); }
        const int nblk = N / 32, kb = r / nblk, nb = r % nblk;
        transpose_block(W, N, 64 * kb, 32 * nb, dst, K, 32 * nb, scr, F.lane);
    }
}
__device__ __forceinline__ void convert_wm(KArgs A, Frame& F, int l) {
    LAS float* scr = (LAS float*)(F.lds + F.wave * 16384);
    const int gw = F.vcu * NWAVES + F.wave, NGW = F.G * NWAVES;
    constexpr int IE = 256;
    for (int it = gw; it < NE * 3 * IE; it += NGW) {
        const int e = it / (3 * IE), r3 = it % (3 * IE), which = r3 / IE, r = r3 % IE;
        if (which < 2) {
            const float* W = (which == 0 ? IN(29) : IN(30)) + ((size_t)l * NE + e) * D * DE;
            const int kb = r / 16, nb = r % 16, n0 = 32 * nb;
            const int drow0 = e * 1024 + (n0 >> 7) * 256 + which * 128 + (n0 & 127);
            transpose_block(W, DE, 64 * kb, n0, (bf16*)(F.ws + WS_WMA), D, drow0, scr, F.lane);
        } else {
            const float* W = IN(31) + ((size_t)l * NE + e) * DE * D;
            const int kb = r / 32, nb = r % 32, n0 = 32 * nb;
            transpose_block(W, D, 64 * kb, n0, (bf16*)(F.ws + WS_WMB), DE, e * 1024 + n0, scr, F.lane);
        }
    }
}
__device__ __forceinline__ void ln_store(f32x4 (&v)[4], const float* g, const float* b, float* xo, bf16* xn, int lane) {
    float s = 0.f;
#pragma unroll
    for (int j = 0; j < 4; ++j) s += (v[j].x + v[j].y) + (v[j].z + v[j].w);
    const float mean = wave_sum(s) * (1.f / D); float s2 = 0.f;
#pragma unroll
    for (int j = 0; j < 4; ++j) { v[j] = v[j] - mean; s2 += (v[j].x * v[j].x + v[j].y * v[j].y) + (v[j].z * v[j].z + v[j].w * v[j].w); }
    const float rstd = 1.f / sqrtf(wave_sum(s2) * (1.f / D) + LN_EPS);
#pragma unroll
    for (int j = 0; j < 4; ++j) { const f32x4 gg = *(const f32x4*)(g + 4 * lane + 256 * j), bb = *(const f32x4*)(b + 4 * lane + 256 * j);
        v[j] = v[j] * rstd * gg + bb;
        *(f32x4*)(xo + 4 * lane + 256 * j) = v[j];
        u32x2 w; w.x = pk2(v[j].x, v[j].y); w.y = pk2(v[j].z, v[j].w); *(u32x2*)(xn + 4 * lane + 256 * j) = w; }
}
__device__ __forceinline__ void p0_prologue(KArgs A, Frame& F) {
    convert_wa(A, F, 0);
    const int gw = F.vcu * NWAVES + F.wave, NGW = F.G * NWAVES, lane = F.lane;
    for (int m = gw; m < T; m += NGW) {
        const float* xr = IN(0) + (size_t)m * D; f32x4 v[4];
#pragma unroll
        for (int j = 0; j < 4; ++j) v[j] = *(const f32x4*)(xr + 4 * lane + 256 * j);
        ln_store(v, IN(2), IN(3), F.X + (size_t)m * D, (bf16*)(F.ws + WS_XN) + (size_t)m * D, lane);
    }
    for (int m = gw; m < MEMT; m += NGW) {
        const float* xr = IN(1) + (size_t)m * D; bf16* o = (bf16*)(F.ws + WS_MEMB) + (size_t)m * D;
#pragma unroll
        for (int j = 0; j < 4; ++j) { const f32x4 v = *(const f32x4*)(xr + 4 * lane + 256 * j); u32x2 w; w.x = pk2(v.x, v.y); w.y = pk2(v.z, v.w); *(u32x2*)(o + 4 * lane + 256 * j) = w; }
    }
    float* ctab = (float*)(F.ws + WS_ROPE); float* stab = ctab + SEQ * 64;
    for (int i = blockIdx.x * (NWAVES * 64) + F.tid; i < SEQ * 64; i += F.G * NWAVES * 64) {
        const int pos = i >> 6, j = i & 63;
        const float invf = exp2f(-(float)j * (13.287712379549449f / 64.f));
        const double rev = (double)((float)pos * invf) * 0.15915494309189535;
        const float fr = (float)(rev - floor(rev));
        ctab[i] = __builtin_amdgcn_cosf(fr); stab[i] = __builtin_amdgcn_sinf(fr);
    }
}

__device__ __forceinline__ void rwkv_prep(KArgs A, Frame& F, int l, int bi, int nb) {
    const int tid = F.tid, lane = F.lane;
    const int cb = bi & 3;
    LAS bf16* wl = (LAS bf16*)F.lds; LAS float* act = (LAS float*)(F.lds + 65536);
    const float* wup = IN(9) + (size_t)l * 64 * RW_W; const float* aup = IN(11) + (size_t)l * 64 * RW_W; const float* gup = IN(13) + (size_t)l * 128 * RW_W;
    for (int i = tid; i < 256 * 128; i += NWAVES * 64) { const int k = i >> 7, c = i & 127;
        const float v = (k < 64) ? wup[(size_t)k * RW_W + 128 * cb + c] : (k < 128) ? aup[(size_t)(k - 64) * RW_W + 128 * cb + c] : gup[(size_t)(k - 128) * RW_W + 128 * cb + c];
        wl[i] = (bf16)f2bf(v); }
    const bf16* P = (const bf16*)(F.ws + WS_PRW);
    const float* mu = IN(8) + (size_t)l * RW_COLS;
    const float* w0 = IN(10) + (size_t)l * RW_W; const float* a0 = IN(12) + (size_t)l * RW_W;
    const float* k_k = IN(14) + (size_t)l * RW_W; const float* k_a = IN(15) + (size_t)l * RW_W; const float* r_k = IN(16) + (size_t)l * RW_W;
    bf16* SI = (bf16*)(F.ws + WS_SI); bf16* Gb = (bf16*)(F.ws + WS_G); float* RB = (float*)(F.ws + WS_RB); float* SC = (float*)(F.ws + WS_SC);
    const int cg = tid & 31, tg = tid >> 5;
    for (int tt = (bi >> 2); tt < T / 64; tt += (nb >> 2)) {
        __syncthreads();
        {
            const int c = tid >> 3, p = tid & 7; const int t = 64 * tt + c; const bool first = (t & (SEQ - 1)) == 0;
            const bf16* pr = P + (size_t)t * RW_COLS + 1536 + 32 * p; const bf16* pp = pr - RW_COLS;
#pragma unroll 1
            for (int q = 0; q < 4; ++q) {
                const v4u a = *(const v4u*)(pr + 8 * q); v4u b = {0u, 0u, 0u, 0u}; if (!first) b = *(const v4u*)(pp + 8 * q);
                const unsigned aw[4] = {a.x, a.y, a.z, a.w}, bw[4] = {b.x, b.y, b.z, b.w};
#pragma unroll
                for (int z = 0; z < 8; ++z) { const int i = 32 * p + 8 * q + z;
                    const float cur = (z & 1) ? bfh(aw[z >> 1]) : bfl(aw[z >> 1]), prv = (z & 1) ? bfh(bw[z >> 1]) : bfl(bw[z >> 1]);
                    float x = cur + mu[1536 + i] * (prv - cur);
                    if (i < 64) { const float e2 = __builtin_amdgcn_exp2f(2.f * 1.44269504f * x); x = 1.f - 2.f * __builtin_amdgcn_rcpf(e2 + 1.f); }
                    else if (i >= 128) x = __builtin_amdgcn_rcpf(1.f + __builtin_amdgcn_exp2f(-1.44269504f * x));
                    act[i * 64 + c] = x; }
            }
        }
        __syncthreads();
        float ww[4][4], aa[4][4], gg[4][4];
#pragma unroll
        for (int a = 0; a < 4; ++a)
#pragma unroll
            for (int b = 0; b < 4; ++b) { ww[a][b] = 0.f; aa[a][b] = 0.f; gg[a][b] = 0.f; }
#pragma unroll 4
        for (int k = 0; k < 64; ++k) {
            const f32x4 x1 = *(const LAS f32x4*)(act + k * 64 + 4 * tg), x2 = *(const LAS f32x4*)(act + (64 + k) * 64 + 4 * tg);
            const u32x2 w1 = *(const LAS u32x2*)(wl + k * 128 + 4 * cg), w2 = *(const LAS u32x2*)(wl + (64 + k) * 128 + 4 * cg);
            const float c1[4] = {bfl(w1.x), bfh(w1.x), bfl(w1.y), bfh(w1.y)}, c2[4] = {bfl(w2.x), bfh(w2.x), bfl(w2.y), bfh(w2.y)};
#pragma unroll
            for (int a = 0; a < 4; ++a)
#pragma unroll
                for (int b = 0; b < 4; ++b) { ww[a][b] += x1[a] * c1[b]; aa[a][b] += x2[a] * c2[b]; }
        }
#pragma unroll 4
        for (int k = 0; k < 128; ++k) {
            const f32x4 x3 = *(const LAS f32x4*)(act + (128 + k) * 64 + 4 * tg);
            const u32x2 w3 = *(const LAS u32x2*)(wl + (128 + k) * 128 + 4 * cg);
            const float c3[4] = {bfl(w3.x), bfh(w3.x), bfl(w3.y), bfh(w3.y)};
#pragma unroll
            for (int a = 0; a < 4; ++a)
#pragma unroll
                for (int b = 0; b < 4; ++b) gg[a][b] += x3[a] * c3[b];
        }
        const int col0 = 128 * cb + 4 * cg, h = col0 >> 6, kidx = col0 & 63;
        __syncthreads();
        {
            const f32x4 w0v = *(const f32x4*)(w0 + col0), a0v = *(const f32x4*)(a0 + col0);
#pragma unroll
            for (int a = 0; a < 4; ++a) {
                *(LAS f32x4*)(act + (4 * tg + a) * 128 + 4 * cg) = (f32x4){ww[a][0] + w0v[0], ww[a][1] + w0v[1], ww[a][2] + w0v[2], ww[a][3] + w0v[3]};
                *(LAS f32x4*)(act + 8192 + (4 * tg + a) * 128 + 4 * cg) = (f32x4){aa[a][0] + a0v[0], aa[a][1] + a0v[1], aa[a][2] + a0v[2], aa[a][3] + a0v[3]};
                u32x2 o; o.x = pk2(gg[a][0], gg[a][1]); o.y = pk2(gg[a][2], gg[a][3]); *(u32x2*)(Gb + (size_t)(64 * tt + 4 * tg + a) * RW_W + col0) = o;
            }
        }
#pragma unroll 1
        for (int a = 0; a < 4; ++a) {
            const f32x4 kkv = *(const f32x4*)(k_k + col0), kav = *(const f32x4*)(k_a + col0), rkv = *(const f32x4*)(r_k + col0);
            const f32x4 mur = *(const f32x4*)(mu + col0), muk = *(const f32x4*)(mu + 512 + col0), muv = *(const f32x4*)(mu + 1024 + col0);
            const f32x4 wv4 = *(const LAS f32x4*)(act + (4 * tg + a) * 128 + 4 * cg), av4 = *(const LAS f32x4*)(act + 8192 + (4 * tg + a) * 128 + 4 * cg);
            const int t = 64 * tt + 4 * tg + a; const bool first = (t & (SEQ - 1)) == 0; const int b = t >> 11, s = t & (SEQ - 1);
            const bf16* pr = P + (size_t)t * RW_COLS + col0; const bf16* pp = pr - RW_COLS;
            const u32x2 r2 = *(const u32x2*)pr, k2 = *(const u32x2*)(pr + 512), v2 = *(const u32x2*)(pr + 1024);
            u32x2 rp = {0u, 0u}, kp = {0u, 0u}, vp = {0u, 0u}; if (!first) { rp = *(const u32x2*)pp; kp = *(const u32x2*)(pp + 512); vp = *(const u32x2*)(pp + 1024); }
            const float rc[4] = {bfl(r2.x), bfh(r2.x), bfl(r2.y), bfh(r2.y)}, rq[4] = {bfl(rp.x), bfh(rp.x), bfl(rp.y), bfh(rp.y)};
            const float kc[4] = {bfl(k2.x), bfh(k2.x), bfl(k2.y), bfh(k2.y)}, kq[4] = {bfl(kp.x), bfh(kp.x), bfl(kp.y), bfh(kp.y)};
            const float vc[4] = {bfl(v2.x), bfh(v2.x), bfl(v2.y), bfh(v2.y)}, vq[4] = {bfl(vp.x), bfh(vp.x), bfl(vp.y), bfh(vp.y)};
            float r[4], k[4], v[4], kk[4], om[4], av[4]; float ssq = 0.f;
#pragma unroll
            for (int c = 0; c < 4; ++c) {
                r[c] = rc[c] + mur[c] * (rq[c] - rc[c]); k[c] = kc[c] + muk[c] * (kq[c] - kc[c]); v[c] = vc[c] + muv[c] * (vq[c] - vc[c]);
                const float wv = wv4[c];
                const float wlog = -0.69314718f * __builtin_amdgcn_logf(1.f + __builtin_amdgcn_exp2f(-1.44269504f * wv)) - 0.5f;
                const float e = __builtin_amdgcn_exp2f(1.44269504f * wlog);
                om[c] = 1.f - __builtin_amdgcn_exp2f(-1.44269504f * e);
                av[c] = __builtin_amdgcn_rcpf(1.f + __builtin_amdgcn_exp2f(-1.44269504f * av4[c]));
                kk[c] = k[c] * kkv[c]; ssq += kk[c] * kk[c];
            }
            ssq = row_sum16(ssq);
            const float rn = 1.f / fmaxf(sqrtf(ssq), 1e-12f);
            float kt[4], nbv[4], wr[4]; float bon = 0.f, c1 = 0.f, c2 = 0.f;
#pragma unroll
            for (int c = 0; c < 4; ++c) { kk[c] *= rn; kt[c] = k[c] * (1.f + (av[c] - 1.f) * kav[c]); nbv[c] = -kk[c] * av[c]; bon += r[c] * kt[c] * rkv[c]; wr[c] = (1.f - om[c]) * r[c]; c1 += nbv[c] * r[c]; c2 += kt[c] * r[c]; }
            bon = row_sum16(bon); c1 = row_sum16(c1); c2 = row_sum16(c2);
            if ((cg & 15) == 0) { RB[(size_t)t * 8 + h] = bon; *(f32x2*)(SC + ((size_t)(b * RW_H + h) * SEQ + s) * 2) = (f32x2){c1, c2}; }
            bf16* sp = SI + ((size_t)(b * RW_H + h) * SEQ + s) * 384 + kidx;
            u32x2 o;
            o.x = pk2(kk[0], kk[1]); o.y = pk2(kk[2], kk[3]); *(u32x2*)(sp) = o;
            o.x = pk2(wr[0], wr[1]); o.y = pk2(wr[2], wr[3]); *(u32x2*)(sp + 64) = o;
            o.x = pk2(nbv[0], nbv[1]); o.y = pk2(nbv[2], nbv[3]); *(u32x2*)(sp + 128) = o;
            o.x = pk2(kt[0], kt[1]); o.y = pk2(kt[2], kt[3]); *(u32x2*)(sp + 192) = o;
            o.x = pk2(om[0], om[1]); o.y = pk2(om[2], om[3]); *(u32x2*)(sp + 256) = o;
            o.x = pk2(v[0], v[1]); o.y = pk2(v[2], v[3]); *(u32x2*)(sp + 320) = o;
        }
    }
    __syncthreads();
}
__device__ __forceinline__ unsigned off_b(unsigned row, unsigned ch) { return 256u * row + 16u * (ch ^ (((row & 3u) << 2) | ((row >> 2) & 3u))); }
__device__ __forceinline__ void retention_unit(KArgs A, Frame& F, int l, int bh) {
    typedef float f32x16 __attribute__((ext_vector_type(16))); typedef short s16x4 __attribute__((ext_vector_type(4))); typedef short v4i16_t __attribute__((ext_vector_type(4)));
    const int tid = F.tid, lane = F.lane, wave = F.wave, r = lane & 31, hh = lane >> 5, cb = wave >> 2, eb = wave & 3;
    const int b = bh >> 2, h = bh & 3;
    LAS unsigned char* Qs = F.lds; LAS unsigned char* Ks = F.lds + 16384; LAS unsigned char* Kd = F.lds + 32768; LAS unsigned char* Vs = F.lds + 49152; LAS unsigned char* Gs = F.lds + 65536;
    LAS unsigned char* Stt = F.lds + 81920; LAS float* red1 = (LAS float*)(F.lds + 114688); LAS float* red2 = (LAS float*)(F.lds + 115712);
    const bf16* P = (const bf16*)(F.ws + WS_PRET); bf16* YR = (bf16*)(F.ws + WS_YR);
    const float* ctab = (const float*)(F.ws + WS_ROPE); const float* stab = ctab + SEQ * 64;
    const float gnw = (IN(7) + (size_t)l * RET_W + h * RET_HD)[32 * eb + r];
    const float lg = __builtin_amdgcn_logf(1.f - exp2f(-5.f - (float)h));
    const float gC = exp2f(lg * 64.f);
    { unsigned z_ = 0u; asm volatile("" : "+v"(z_)); for (int i = tid; i < 32768 / 16; i += NWAVES * 64) ((LAS v4u*)Stt)[i] = (v4u){z_, z_, z_, z_}; }
    f32x16 st0, st1;
#pragma unroll
    for (int i = 0; i < 16; ++i) { st0[i] = 0.f; st1[i] = 0.f; }
    const int sc = tid >> 3, sp = tid & 7;
    const int blk = (lane >> 4) & 1, tq = (lane & 15) >> 2, tp = lane & 3;
    const unsigned fr = ((r & 3) << 2) | ((r >> 2) & 3), fs = ((sc & 3) << 2) | ((sc >> 2) & 3);
    const unsigned lds0 = (unsigned)(uintptr_t)F.lds;
    unsigned aQ = lds0 + 256 * (32 * cb + r) + 16 * (hh ^ fr);
    unsigned aK = lds0 + 16384 + 256 * r + 16 * (hh ^ fr);
    unsigned aS = lds0 + 81920 + 256 * (32 * eb + r) + 16 * (hh ^ fr);
    unsigned aV2 = lds0 + 49152 + 256 * (4 * hh + tq) + 16 * ((4 * eb + 2 * blk + (tp >> 1)) ^ ((tq << 2) | hh)) + 8 * (tp & 1);
    unsigned aV4 = lds0 + 49152 + 256 * (8 * hh + tq) + 16 * ((4 * eb + 2 * blk + (tp >> 1)) ^ ((tq << 2) | (2 * hh))) + 8 * (tp & 1);
    unsigned aK4 = lds0 + 32768 + 256 * (8 * hh + tq) + 16 * ((8 * cb + 2 * blk + (tp >> 1)) ^ ((tq << 2) | (2 * hh))) + 8 * (tp & 1);
    unsigned aW = lds0 + 81920 + 256 * (32 * eb + r) + 16 * ((8 * cb) ^ fr) + 8 * hh;
    unsigned aW1 = lds0 + 256 * sc + 16 * (sp ^ fs);
    unsigned aWv = lds0 + 49152 + 256 * sc + 16 * ((2 * sp) ^ fs);
    unsigned aG = lds0 + 65536 + 256 * (32 * cb + 4 * hh) + 2 * (32 * eb + r);
    unsigned aR = lds0 + 114688 + 16 * (32 * cb + 4 * hh);
#define LD128(a) (*(const LAS bf16x8*)(uintptr_t)(a))
#define LDTR(a) __builtin_bit_cast(s16x4, __builtin_amdgcn_ds_read_tr16_b64_v4i16((LAS v4i16_t*)(uintptr_t)(a)))
    v4u fq1, fq2, fk1, fk2, fv1, fv2, fg1, fg2; f32x4 pc0, pc1, ps0, ps1;
#define RET_LOAD(n) do { const int s_ = (n) * CHUNK + sc; const bf16* pr_ = P + ((size_t)b * SEQ + s_) * 2048 + h * RET_HD; \
        fq1 = *(const v4u*)(pr_ + 8 * sp); fq2 = *(const v4u*)(pr_ + 64 + 8 * sp); fk1 = *(const v4u*)(pr_ + 512 + 8 * sp); fk2 = *(const v4u*)(pr_ + 576 + 8 * sp); \
        fv1 = *(const v4u*)(pr_ + 1024 + 16 * sp); fv2 = *(const v4u*)(pr_ + 1032 + 16 * sp); } while (0)
#define RET_LOAD2(n) do { const int s_ = (n) * CHUNK + sc; const bf16* pr_ = P + ((size_t)b * SEQ + s_) * 2048 + h * RET_HD; fg1 = *(const v4u*)(pr_ + 1536 + 16 * sp); fg2 = *(const v4u*)(pr_ + 1544 + 16 * sp); \
        pc0 = *(const f32x4*)(ctab + s_ * 64 + 8 * sp); pc1 = *(const f32x4*)(ctab + s_ * 64 + 8 * sp + 4); ps0 = *(const f32x4*)(stab + s_ * 64 + 8 * sp); ps1 = *(const f32x4*)(stab + s_ * 64 + 8 * sp + 4); } while (0)
    RET_LOAD(0);
    const int cpos = 32 * cb + r;
#pragma unroll 1
    for (int n = 0; n < NCHUNK; ++n) {
        asm volatile("" : "+v"(aQ), "+v"(aK), "+v"(aS), "+v"(aV2), "+v"(aV4), "+v"(aK4), "+v"(aW), "+v"(aW1), "+v"(aWv), "+v"(aG), "+v"(aR));
        RET_LOAD2(n);
        __syncthreads();
        {
            const unsigned qa[4] = {fq1.x, fq1.y, fq1.z, fq1.w}, qb[4] = {fq2.x, fq2.y, fq2.z, fq2.w}, ka[4] = {fk1.x, fk1.y, fk1.z, fk1.w}, kb[4] = {fk2.x, fk2.y, fk2.z, fk2.w};
            const float cs[8] = {pc0.x, pc0.y, pc0.z, pc0.w, pc1.x, pc1.y, pc1.z, pc1.w}, sn[8] = {ps0.x, ps0.y, ps0.z, ps0.w, ps1.x, ps1.y, ps1.z, ps1.w};
            const float kdec = __builtin_amdgcn_exp2f(lg * (float)(63 - sc));
            unsigned o1[4], o2[4], o3[4], o4[4], o5[4], o6[4];
#pragma unroll
            for (int z = 0; z < 4; ++z) {
                const float a0 = bfl(qa[z]), a1 = bfh(qa[z]), b0 = bfl(qb[z]), b1 = bfh(qb[z]);
                o1[z] = pk2(a0 * cs[2 * z] - b0 * sn[2 * z], a1 * cs[2 * z + 1] - b1 * sn[2 * z + 1]);
                o2[z] = pk2(a0 * sn[2 * z] + b0 * cs[2 * z], a1 * sn[2 * z + 1] + b1 * cs[2 * z + 1]);
                const float e0 = bfl(ka[z]) * 0.08838834764831845f, e1 = bfh(ka[z]) * 0.08838834764831845f, f0 = bfl(kb[z]) * 0.08838834764831845f, f1 = bfh(kb[z]) * 0.08838834764831845f;
                const float x0 = e0 * cs[2 * z] - f0 * sn[2 * z], x1 = e1 * cs[2 * z + 1] - f1 * sn[2 * z + 1], y0 = e0 * sn[2 * z] + f0 * cs[2 * z], y1 = e1 * sn[2 * z + 1] + f1 * cs[2 * z + 1];
                o3[z] = pk2(x0, x1); o4[z] = pk2(y0, y1); o5[z] = pk2(x0 * kdec, x1 * kdec); o6[z] = pk2(y0 * kdec, y1 * kdec);
            }
#define ST128(a, v) (*(LAS v4u*)(uintptr_t)(a) = (v))
            ST128(aW1, ((v4u){o1[0], o1[1], o1[2], o1[3]})); ST128(aW1 ^ 128, ((v4u){o2[0], o2[1], o2[2], o2[3]}));
            ST128(aW1 + 16384, ((v4u){o3[0], o3[1], o3[2], o3[3]})); ST128((aW1 ^ 128) + 16384, ((v4u){o4[0], o4[1], o4[2], o4[3]}));
            ST128(aW1 + 32768, ((v4u){o5[0], o5[1], o5[2], o5[3]})); ST128((aW1 ^ 128) + 32768, ((v4u){o6[0], o6[1], o6[2], o6[3]}));
            ST128(aWv, fv1); ST128(aWv ^ 16, fv2);
            *(LAS v4u*)(Gs + sc * 256 + 32 * sp) = fg1; *(LAS v4u*)(Gs + sc * 256 + 32 * sp + 16) = fg2;
        }
        if (n + 1 < NCHUNK) RET_LOAD(n + 1);
        __syncthreads();
        bf16x8 qf[8];
#pragma unroll
        for (int s = 0; s < 8; ++s) qf[s] = LD128(aQ ^ (32 * s));
        f32x16 p0, p1;
#pragma unroll
        for (int i = 0; i < 16; ++i) { p0[i] = 0.f; p1[i] = 0.f; }
#pragma unroll
        for (int s = 0; s < 8; ++s) { const bf16x8 a0 = LD128(aK ^ (32 * s)), a1 = LD128((aK ^ (32 * s)) + 8192);
            p0 = __builtin_amdgcn_mfma_f32_32x32x16_bf16(a0, qf[s], p0, 0, 0, 0); p1 = __builtin_amdgcn_mfma_f32_32x32x16_bf16(a1, qf[s], p1, 0, 0, 0); }
#pragma unroll
        for (int i = 0; i < 16; ++i) { const int m0 = (i & 3) + 8 * (i >> 2) + 4 * hh; const int d0 = cpos > m0 ? cpos - m0 : m0 - cpos, d1 = cpos > m0 + 32 ? cpos - m0 - 32 : m0 + 32 - cpos;
            p0[i] *= __builtin_amdgcn_exp2f(lg * (float)d0); p1[i] *= __builtin_amdgcn_exp2f(lg * (float)d1); }
        bf16x8 pf[4];
#pragma unroll
        for (int s = 0; s < 4; ++s) { const int o = 8 * (s & 1); v4u w;
            if (s < 2) { w.x = pk2(p0[o + 0], p0[o + 1]); w.y = pk2(p0[o + 2], p0[o + 3]); w.z = pk2(p0[o + 4], p0[o + 5]); w.w = pk2(p0[o + 6], p0[o + 7]); }
            else { w.x = pk2(p1[o + 0], p1[o + 1]); w.y = pk2(p1[o + 2], p1[o + 3]); w.z = pk2(p1[o + 4], p1[o + 5]); w.w = pk2(p1[o + 6], p1[o + 7]); }
            pf[s] = __builtin_bit_cast(bf16x8, w); }
        f32x16 yi;
#pragma unroll
        for (int i = 0; i < 16; ++i) yi[i] = 0.f;
#pragma unroll
        for (int s = 0; s < 4; ++s) {
            const s16x4 lo = LDTR(aV2 + 4096 * s), hi = LDTR((aV2 ^ 32) + 2048 + 4096 * s);
            const bf16x8 vf = {lo[0], lo[1], lo[2], lo[3], hi[0], hi[1], hi[2], hi[3]};
            yi = __builtin_amdgcn_mfma_f32_32x32x16_bf16(pf[s], vf, yi, 0, 0, 0); }
        f32x16 yc;
#pragma unroll
        for (int i = 0; i < 16; ++i) yc[i] = 0.f;
#pragma unroll
        for (int s = 0; s < 8; ++s) { const bf16x8 sf = LD128(aS ^ (32 * s)); yc = __builtin_amdgcn_mfma_f32_32x32x16_bf16(qf[s], sf, yc, 0, 0, 0); }
#pragma unroll
        for (int i = 0; i < 16; ++i) { const int c = 32 * cb + (i & 3) + 8 * (i >> 2) + 4 * hh; yi[i] += __builtin_amdgcn_exp2f(lg * (float)(c + 1)) * yc[i]; }
#pragma unroll
        for (int i = 0; i < 16; ++i) { float s1 = row_sum16(yi[i]), s2 = row_sum16(yi[i] * yi[i]); s1 += __shfl_xor(s1, 16); s2 += __shfl_xor(s2, 16);
            if (r == 0) { LAS float* rp = (LAS float*)(uintptr_t)(aR + 16 * ((i & 3) + 8 * (i >> 2)) + 4 * eb); rp[0] = s1; rp[256] = s2; } }
        __syncthreads();
        st0 = st0 * gC; st1 = st1 * gC;
#pragma unroll
        for (int s = 0; s < 4; ++s) {
            const s16x4 v0 = LDTR(aV4 + 4096 * s), v1 = LDTR((aV4 ^ 16) + 1024 + 4096 * s);
            const bf16x8 vf = {v0[0], v0[1], v0[2], v0[3], v1[0], v1[1], v1[2], v1[3]};
            const s16x4 k0 = LDTR(aK4 + 4096 * s), k1 = LDTR((aK4 ^ 16) + 1024 + 4096 * s), k2 = LDTR((aK4 ^ 64) + 4096 * s), k3 = LDTR((aK4 ^ 64 ^ 16) + 1024 + 4096 * s);
            const bf16x8 kf0 = {k0[0], k0[1], k0[2], k0[3], k1[0], k1[1], k1[2], k1[3]}, kf1 = {k2[0], k2[1], k2[2], k2[3], k3[0], k3[1], k3[2], k3[3]};
            st0 = __builtin_amdgcn_mfma_f32_32x32x16_bf16(kf0, vf, st0, 0, 0, 0); st1 = __builtin_amdgcn_mfma_f32_32x32x16_bf16(kf1, vf, st1, 0, 0, 0); }
#pragma unroll
        for (int g = 0; g < 4; ++g) { u32x2 w0, w1; w0.x = pk2(st0[4 * g], st0[4 * g + 1]); w0.y = pk2(st0[4 * g + 2], st0[4 * g + 3]); w1.x = pk2(st1[4 * g], st1[4 * g + 1]); w1.y = pk2(st1[4 * g + 2], st1[4 * g + 3]);
            *(LAS u32x2*)(uintptr_t)(aW ^ (16 * g)) = w0; *(LAS u32x2*)(uintptr_t)(aW ^ 64 ^ (16 * g)) = w1; }
#pragma unroll
        for (int i = 0; i < 16; ++i) { const int cl = (i & 3) + 8 * (i >> 2);
            const f32x4 a1 = *(const LAS f32x4*)(uintptr_t)(aR + 16 * cl), a2 = *(const LAS f32x4*)(uintptr_t)(aR + 1024 + 16 * cl);
            const float mean = ((a1.x + a1.y) + (a1.z + a1.w)) * (1.f / 128.f), var = fmaxf(((a2.x + a2.y) + (a2.z + a2.w)) * (1.f / 128.f) - mean * mean, 0.f), rstd = 1.f / sqrtf(var + LN_EPS);
            const float g = bf1(*(const LAS bf16*)(uintptr_t)(aG + 256 * cl));
            const size_t t = (size_t)b * SEQ + n * CHUNK + 32 * cb + 4 * hh + cl;
            YR[t * RET_W + h * RET_HD + 32 * eb + r] = (bf16)f2bf((yi[i] - mean) * rstd * gnw * (g * sigm(g))); }
    }
#undef LD128
#undef LDTR
#undef ST128
#undef RET_LOAD
#undef RET_LOAD2
    __syncthreads();
}

__device__ __forceinline__ void rwkv_scan(Frame& F) {
    constexpr int NB = 32, REC = 1360, BUF = NB * REC;
    const int lane = F.lane, wave = F.wave, bh = F.vcu >> 2, rq = F.vcu & 3;
    const bf16* sp = (const bf16*)(F.ws + WS_SI) + (size_t)bh * SEQ * 384;
    const float* scp = (const float*)(F.ws + WS_SC) + (size_t)bh * SEQ * 2;
    float* yraw = (float*)(F.ws + WS_YRAW) + (size_t)(bh >> 3) * SEQ * RW_W + (bh & 7) * RW_HD + 16 * rq;
    LAS unsigned char* ring = F.lds; LAS float* ybuf = (LAS float*)(F.lds + 2 * BUF);
    const bool loader = wave >= 4; const int lt = F.tid - 256;
    const int j = lane & 15, rl = lane >> 4;
    float s0 = 0.f, s1 = 0.f, s2 = 0.f, s3 = 0.f;
#define SCAN_FILL(blk) do { LAS unsigned char* dst_ = ring + ((blk) & 1) * BUF; const bf16* src_ = sp + (size_t)(blk) * NB * 384; \
        _Pragma("unroll") for (int i_ = 0; i_ < 6; ++i_) { const int q_ = lt + 256 * i_, rec_ = q_ / 48, pc_ = q_ % 48, vec_ = pc_ >> 3, part_ = pc_ & 7; \
            const v4u x_ = *(const v4u*)(src_ + rec_ * 384 + pc_ * 8); \
            f32x4 a_ = {bfl(x_.x), bfh(x_.x), bfl(x_.y), bfh(x_.y)}, b_ = {bfl(x_.z), bfh(x_.z), bfl(x_.w), bfh(x_.w)}; \
            if (vec_ == 4) { a_ = 1.f - a_; b_ = 1.f - b_; } \
            if (vec_ < 5) { *(LAS f32x4*)(dst_ + rec_ * REC + vec_ * 256 + part_ * 32) = a_; *(LAS f32x4*)(dst_ + rec_ * REC + vec_ * 256 + part_ * 32 + 16) = b_; } \
            else if ((part_ >> 1) == rq) { *(LAS f32x4*)(dst_ + rec_ * REC + 1280 + (part_ & 1) * 32) = a_; *(LAS f32x4*)(dst_ + rec_ * REC + 1280 + (part_ & 1) * 32 + 16) = b_; } } \
        if (lt < NB) { *(LAS f32x2*)(dst_ + lt * REC + 1344) = *(const f32x2*)(scp + ((size_t)(blk) * NB + lt) * 2); } } while (0)
    if (loader) SCAN_FILL(0);
    __syncthreads();
#pragma unroll 1
    for (int blk = 0; blk < SEQ / NB; ++blk) {
        if (loader) {
            if (blk + 1 < SEQ / NB) SCAN_FILL(blk + 1);
            if (blk > 0) { const int u = lt >> 3, part = lt & 7;
                const f32x2 yv = *(const LAS f32x2*)(ybuf + ((blk - 1) & 1) * (NB * 16) + u * 16 + 2 * part);
                *(f32x2*)(yraw + (size_t)((blk - 1) * NB + u) * RW_W + 2 * part) = yv; }
        } else {
            const LAS unsigned char* rec = ring + (blk & 1) * BUF + 16 * j; const LAS unsigned char* recv = ring + (blk & 1) * BUF + 1280 + 4 * (4 * wave + rl); const LAS unsigned char* recc = ring + (blk & 1) * BUF + 1344;
            LAS unsigned char* ya = (j == 0) ? (LAS unsigned char*)(ybuf + (blk & 1) * (NB * 16) + 4 * wave + rl) : (F.lds + 2 * BUF + 4096 + (wave * 64 + lane) * 4);
#define SC_LOAD(S, u) S##kk = *(const LAS f32x4*)(rec + (u) * REC); S##wr = *(const LAS f32x4*)(rec + (u) * REC + 256); S##nb = *(const LAS f32x4*)(rec + (u) * REC + 512); S##kt = *(const LAS f32x4*)(rec + (u) * REC + 768); \
            S##w = *(const LAS f32x4*)(rec + (u) * REC + 1024); S##vv = *(const LAS float*)(recv + (u) * REC); S##cc = *(const LAS f32x2*)(recc + (u) * REC)
#define SC_STEP(S, u) do { float d1 = (s0 * S##kk.x + s1 * S##kk.y) + (s2 * S##kk.z + s3 * S##kk.w), d2 = (s0 * S##wr.x + s1 * S##wr.y) + (s2 * S##wr.z + s3 * S##wr.w); \
            d1 = row_sum16(d1); d2 = row_sum16(d2); \
            s0 = s0 * S##w.x + d1 * S##nb.x + S##vv * S##kt.x; s1 = s1 * S##w.y + d1 * S##nb.y + S##vv * S##kt.y; s2 = s2 * S##w.z + d1 * S##nb.z + S##vv * S##kt.z; s3 = s3 * S##w.w + d1 * S##nb.w + S##vv * S##kt.w; \
            *(LAS float*)(ya + (u) * 64) = d2 + d1 * S##cc.x + S##vv * S##cc.y; } while (0)
            f32x4 Akk, Awr, Anb, Akt, Aw, Bkk, Bwr, Bnb, Bkt, Bw, Ckk, Cwr, Cnb, Ckt, Cw, Dkk, Dwr, Dnb, Dkt, Dw; float Avv, Bvv, Cvv, Dvv; f32x2 Acc, Bcc, Ccc, Dcc;
            SC_LOAD(A, 0); SC_LOAD(B, 1);
#pragma unroll
            for (int u = 0; u < NB; u += 4) {
                SC_LOAD(C, u + 2); SC_STEP(A, u); SC_LOAD(D, u + 3); SC_STEP(B, u + 1);
                SC_LOAD(A, (u + 4) & (NB - 1)); SC_STEP(C, u + 2); SC_LOAD(B, (u + 5) & (NB - 1)); SC_STEP(D, u + 3);
            }
#undef SC_LOAD
#undef SC_STEP
        }
        __syncthreads();
    }
    if (loader) { const int u = lt >> 3, part = lt & 7; const int blk = SEQ / NB;
        const f32x2 yv = *(const LAS f32x2*)(ybuf + ((blk - 1) & 1) * (NB * 16) + u * 16 + 2 * part);
        *(f32x2*)(yraw + (size_t)((blk - 1) * NB + u) * RW_W + 2 * part) = yv; }
#undef SCAN_FILL
}
__device__ __forceinline__ void rwkv_finish(KArgs A, Frame& F, int l) {
    const int gw = F.vcu * NWAVES + F.wave, NGW = F.G * NWAVES, lane = F.lane, h = lane >> 3, c0 = 8 * lane;
    const float* yraw = (const float*)(F.ws + WS_YRAW); const bf16* SI = (const bf16*)(F.ws + WS_SI); const bf16* Gb = (const bf16*)(F.ws + WS_G); const float* RB = (const float*)(F.ws + WS_RB);
    bf16* YY = (bf16*)(F.ws + WS_YK);
    const float* lng = IN(17) + (size_t)l * RW_W + c0; const float* lnb = IN(18) + (size_t)l * RW_W + c0;
    const f32x4 g0 = *(const f32x4*)lng, g1 = *(const f32x4*)(lng + 4), b0 = *(const f32x4*)lnb, b1 = *(const f32x4*)(lnb + 4);
    const float gv[8] = {g0.x, g0.y, g0.z, g0.w, g1.x, g1.y, g1.z, g1.w}, bv[8] = {b0.x, b0.y, b0.z, b0.w, b1.x, b1.y, b1.z, b1.w};
    for (int t = gw; t < T; t += NGW) {
        const f32x4 y0 = *(const f32x4*)(yraw + (size_t)t * RW_W + c0), y1 = *(const f32x4*)(yraw + (size_t)t * RW_W + c0 + 4);
        float y[8] = {y0.x, y0.y, y0.z, y0.w, y1.x, y1.y, y1.z, y1.w};
        float s = 0.f;
#pragma unroll
        for (int i = 0; i < 8; ++i) s += y[i];
        const float mean = row_sum8(s) * (1.f / 64.f); float q = 0.f;
#pragma unroll
        for (int i = 0; i < 8; ++i) { y[i] -= mean; q += y[i] * y[i]; }
        const float rstd = 1.f / sqrtf(row_sum8(q) * (1.f / 64.f) + RW_GN_EPS);
        const int b = t >> 11, sq = t & (SEQ - 1);
        const v4u vv = *(const v4u*)(SI + ((size_t)(b * RW_H + h) * SEQ + sq) * 384 + 320 + (c0 & 63));
        const v4u gg = *(const v4u*)(Gb + (size_t)t * RW_W + c0);
        const float bon = RB[(size_t)t * 8 + h];
        const unsigned vw[4] = {vv.x, vv.y, vv.z, vv.w}, gwv[4] = {gg.x, gg.y, gg.z, gg.w}; unsigned o[4];
#pragma unroll
        for (int i = 0; i < 4; ++i) {
            const float a0 = (y[2 * i] * rstd * gv[2 * i] + bv[2 * i] + bon * bfl(vw[i])) * bfl(gwv[i]);
            const float a1 = (y[2 * i + 1] * rstd * gv[2 * i + 1] + bv[2 * i + 1] + bon * bfh(vw[i])) * bfh(gwv[i]);
            o[i] = pk2(a0, a1);
        }
        *(v4u*)(YY + (size_t)t * RW_W + c0) = (v4u){o[0], o[1], o[2], o[3]};
    }
}
template <bool ROUTE> __device__ __forceinline__ void ln_phase(KArgs A, Frame& F, int l, const float* g, const float* b) {
    const int gw = F.vcu * NWAVES + F.wave, NGW = F.G * NWAVES, lane = F.lane;
    const float* H1 = (const float*)(F.ws + WS_H1); bf16* XN = (bf16*)(F.ws + WS_XN);
    const float* rw = IN(4); const float* rbias = IN(5);
    int* lists = (int*)(F.ws + WS_LISTS); int* tokinfo = (int*)(F.ws + WS_TOKINFO);
    for (int m = gw; m < T; m += NGW) {
        float* xr = F.X + (size_t)m * D; const float* hr = H1 + (size_t)m * D; f32x4 v[4];
#pragma unroll
        for (int j = 0; j < 4; ++j) v[j] = *(const f32x4*)(xr + 4 * lane + 256 * j) * ALPHA + *(const f32x4*)(hr + 4 * lane + 256 * j);
        ln_store(v, g, b, xr, XN + (size_t)m * D, lane);
        if (ROUTE) {
            float lg[16];
#pragma unroll
            for (int e = 0; e < 16; ++e) lg[e] = 0.f;
#pragma unroll
            for (int j = 0; j < 4; ++j)
#pragma unroll
                for (int q = 0; q < 4; ++q) { const float xv = v[j][q]; const float* wr_ = rw + (size_t)(4 * lane + 256 * j + q) * NE;
                    const f32x4 w0 = *(const f32x4*)wr_, w1 = *(const f32x4*)(wr_ + 4), w2 = *(const f32x4*)(wr_ + 8), w3 = *(const f32x4*)(wr_ + 12);
                    lg[0] += xv * w0.x; lg[1] += xv * w0.y; lg[2] += xv * w0.z; lg[3] += xv * w0.w; lg[4] += xv * w1.x; lg[5] += xv * w1.y; lg[6] += xv * w1.z; lg[7] += xv * w1.w;
                    lg[8] += xv * w2.x; lg[9] += xv * w2.y; lg[10] += xv * w2.z; lg[11] += xv * w2.w; lg[12] += xv * w3.x; lg[13] += xv * w3.y; lg[14] += xv * w3.z; lg[15] += xv * w3.w; }
            float aff[16], ch[16];
#pragma unroll
            for (int e = 0; e < 16; ++e) { lg[e] = wave_sum(lg[e]); aff[e] = 1.f / (1.f + expf(-lg[e])); ch[e] = aff[e] + rbias[e]; }
            float gs[4];
#pragma unroll
            for (int q = 0; q < 4; ++q) { const float a = ch[4 * q], bb = ch[4 * q + 1], c = ch[4 * q + 2], d = ch[4 * q + 3];
                const float hi1 = fmaxf(a, bb), lo1 = fminf(a, bb), hi2 = fmaxf(c, d), lo2 = fminf(c, d);
                gs[q] = fmaxf(hi1, hi2) + fmaxf(fminf(hi1, hi2), fmaxf(lo1, lo2)); }
            int bg = 0; float best = gs[0];
#pragma unroll
            for (int q = 1; q < 4; ++q) if (gs[q] > best) { best = gs[q]; bg = q; }
            float c4[4], a4[4];
#pragma unroll
            for (int i = 0; i < 4; ++i) { c4[i] = bg == 0 ? ch[i] : bg == 1 ? ch[4 + i] : bg == 2 ? ch[8 + i] : ch[12 + i]; a4[i] = bg == 0 ? aff[i] : bg == 1 ? aff[4 + i] : bg == 2 ? aff[8 + i] : aff[12 + i]; }
            int i1 = 0; float m1 = c4[0];
#pragma unroll
            for (int i = 1; i < 4; ++i) if (c4[i] > m1) { m1 = c4[i]; i1 = i; }
            int i2 = -1; float m2 = 0.f;
#pragma unroll
            for (int i = 0; i < 4; ++i) if (i != i1 && (i2 < 0 || c4[i] > m2)) { m2 = c4[i]; i2 = i; }
            const float af1 = i1 == 0 ? a4[0] : i1 == 1 ? a4[1] : i1 == 2 ? a4[2] : a4[3], af2 = i2 == 0 ? a4[0] : i2 == 1 ? a4[1] : i2 == 2 ? a4[2] : a4[3];
            const float inv = 1.f / (af1 + af2);
            if (lane == 0) {
                const int e1 = 4 * bg + i1, e2 = 4 * bg + i2;
                const int p1 = (int)__hip_atomic_fetch_add(F.ctl + CW_CNT + l * 1024 + 64 * e1, 1u, RLX_AGENT);
                const int p2 = (int)__hip_atomic_fetch_add(F.ctl + CW_CNT + l * 1024 + 64 * e2, 1u, RLX_AGENT);
                lists[e1 * T + p1] = m; lists[e2 * T + p2] = m;
                int* ti = tokinfo + (size_t)m * 8;
                ti[0] = e1; ti[1] = p1; ti[2] = __float_as_int(af1 * inv); ti[3] = e2; ti[4] = p2; ti[5] = __float_as_int(af2 * inv);
            }
        }
    }
}
__device__ __forceinline__ void moe_prefix(Frame& F, int l) {
    if (F.tid == 0) { int acc = 0;
        for (int e = 0; e < NE; ++e) { F.MISC[32 + e] = (unsigned)acc; const unsigned c = __hip_atomic_load(F.ctl + CW_CNT + l * 1024 + 64 * e, RLX_AGENT); acc += (int)((c + 255u) >> 8); }
        F.MISC[32 + NE] = (unsigned)acc; }
    __syncthreads();
}
__device__ __forceinline__ void moe_gather(Frame& F, int l) {
    moe_prefix(F, l);
    const int gw = F.vcu * NWAVES + F.wave, NGW = F.G * NWAVES, lane = F.lane;
    const int* lists = (const int*)(F.ws + WS_LISTS); const bf16* XN = (const bf16*)(F.ws + WS_XN); bf16* XG = (bf16*)(F.ws + WS_XG);
    const int nrows = (int)F.MISC[32 + NE] * 256;
    for (int R = gw; R < nrows; R += NGW) {
        const int mt = R >> 8; int e = 0;
#pragma unroll
        for (int q = 1; q < 16; ++q) e += (mt >= (int)F.MISC[32 + q]) ? 1 : 0;
        const int pos = R - (int)F.MISC[32 + e] * 256; const int cnt = (int)__hip_atomic_load(F.ctl + CW_CNT + l * 1024 + 64 * e, RLX_AGENT);
        v4u a = {0u, 0u, 0u, 0u}, b = {0u, 0u, 0u, 0u};
        if (pos < cnt) { const int tok = lists[e * T + pos]; const v4u* src = (const v4u*)(XN + (size_t)tok * D); a = src[lane]; b = src[64 + lane]; }
        v4u* dst = (v4u*)(XG + (size_t)R * D); dst[lane] = a; dst[64 + lane] = b;
    }
}
__device__ __forceinline__ void moe_combine_ln(Frame& F, int l, const float* g, const float* b) {
    moe_prefix(F, l);
    const int gw = F.vcu * NWAVES + F.wave, NGW = F.G * NWAVES, lane = F.lane;
    const int* tokinfo = (const int*)(F.ws + WS_TOKINFO); const bf16* YM = (const bf16*)(F.ws + WS_YM); bf16* XN = (bf16*)(F.ws + WS_XN);
    for (int m = gw; m < T; m += NGW) {
        const int* ti = tokinfo + (size_t)m * 8;
        const int e1 = ti[0], p1 = ti[1], e2 = ti[3], p2 = ti[4]; const float w1 = __int_as_float(ti[2]), w2 = __int_as_float(ti[5]);
        const bf16* y1 = YM + ((size_t)F.MISC[32 + e1] * 256 + p1) * D; const bf16* y2 = YM + ((size_t)F.MISC[32 + e2] * 256 + p2) * D;
        float* xr = F.X + (size_t)m * D; f32x4 v[4];
#pragma unroll
        for (int j = 0; j < 4; ++j) { const u32x2 a = *(const u32x2*)(y1 + 4 * lane + 256 * j), c = *(const u32x2*)(y2 + 4 * lane + 256 * j);
            const f32x4 ya = {bfl(a.x), bfh(a.x), bfl(a.y), bfh(a.y)}, yc = {bfl(c.x), bfh(c.x), bfl(c.y), bfh(c.y)};
            v[j] = *(const f32x4*)(xr + 4 * lane + 256 * j) * ALPHA + ya * w1 + yc * w2; }
        ln_store(v, g, b, xr, XN + (size_t)m * D, lane);
    }
}

__device__ __forceinline__ void attn_phase(Frame& F) {
    typedef float f32x16 __attribute__((ext_vector_type(16)));
    const int u = F.vcu, b = u >> 5, h = (u >> 3) & 3, qb = u & 7, lane = F.lane, wave = F.wave, r = lane & 31, hh = lane >> 5, x = lane & 15;
    if (u >= BATCH * XA_H * 8) return;
    const size_t q0 = (size_t)b * SEQ + qb * 256 + wave * 32;
    const bf16* Qp = (const bf16*)(F.ws + WS_Q) + (q0 + r) * D + h * XA_HD + 8 * hh;
    const bf16* Kg = (const bf16*)(F.ws + WS_MK) + (size_t)b * MEM_LEN * D + h * XA_HD;
    const bf16* Vg = (const bf16*)(F.ws + WS_VT) + (size_t)h * XA_HD * MEMT + b * MEM_LEN;
    bf16* Og = (bf16*)(F.ws + WS_O) + q0 * D + h * XA_HD;
    const unsigned lds0 = (unsigned)(uintptr_t)F.lds;
#define ATT_DMA(G, stride) do { _Pragma("unroll") for (int i_ = 0; i_ < 16; ++i_) { const int rw_ = 32 * wave + 2 * i_ + (lane >> 5); const int ch_ = (lane & 31) ^ (rw_ & 15); \
        __builtin_amdgcn_global_load_lds((const unsigned*)((G) + (size_t)rw_ * (stride) + 8 * ch_), (LAS unsigned*)(F.lds + (32 * wave + 2 * i_) * 512), 16, 0, 0); } } while (0)
    ATT_DMA(Kg, D);
    f32x16 acc[8];
#pragma unroll
    for (int kb = 0; kb < 8; ++kb)
#pragma unroll
        for (int i = 0; i < 16; ++i) acc[kb][i] = 0.f;
    __syncthreads();
    {
        unsigned aK = lds0 + 512 * r + 16 * (hh ^ x); asm volatile("" : "+v"(aK));
#pragma unroll
        for (int s = 0; s < 16; ++s) {
            const bf16x8 qf = *(const bf16x8*)(Qp + 16 * s);
#pragma unroll
            for (int kb = 0; kb < 8; ++kb) { const bf16x8 kf = *(const LAS bf16x8*)(uintptr_t)((aK ^ (32 * s)) + 16384 * kb); acc[kb] = __builtin_amdgcn_mfma_f32_32x32x16_bf16(kf, qf, acc[kb], 0, 0, 0); }
        }
    }
    float mx = -INFINITY;
#pragma unroll
    for (int kb = 0; kb < 8; ++kb)
#pragma unroll
        for (int i = 0; i < 16; ++i) mx = fmaxf(mx, acc[kb][i]);
    mx = fmaxf(mx, __shfl_xor(mx, 32));
    float sum = 0.f;
#pragma unroll
    for (int kb = 0; kb < 8; ++kb)
#pragma unroll
        for (int i = 0; i < 16; ++i) { const float p = __builtin_amdgcn_exp2f(acc[kb][i] - mx); acc[kb][i] = p; sum += p; }
    sum += __shfl_xor(sum, 32);
    const float inv = 1.f / sum;
    bf16x8 pf[16];
#pragma unroll
    for (int s = 0; s < 16; ++s) { const int kb = s >> 1, o = 8 * (s & 1); v4u w;
        w.x = pk2(acc[kb][o + 0] * inv, acc[kb][o + 1] * inv); w.y = pk2(acc[kb][o + 2] * inv, acc[kb][o + 3] * inv); w.z = pk2(acc[kb][o + 4] * inv, acc[kb][o + 5] * inv); w.w = pk2(acc[kb][o + 6] * inv, acc[kb][o + 7] * inv);
        pf[s] = __builtin_bit_cast(bf16x8, w); }
    __syncthreads();
    ATT_DMA(Vg, MEMT);
    __syncthreads();
    {
        unsigned aV = lds0 + 512 * r + 16 * x + 8 * hh; asm volatile("" : "+v"(aV));
        LAS unsigned char* ost = F.lds + 131072 + wave * 2048;
#pragma unroll 1
        for (int db = 0; db < 8; ++db) {
            f32x16 o;
#pragma unroll
            for (int i = 0; i < 16; ++i) o[i] = 0.f;
#pragma unroll
            for (int s = 0; s < 16; ++s) { const u32x2 lo = *(const LAS u32x2*)(uintptr_t)((aV ^ (32 * s)) + 16384 * db), hi = *(const LAS u32x2*)(uintptr_t)((aV ^ (32 * s) ^ 16) + 16384 * db);
                const v4u w = {lo.x, lo.y, hi.x, hi.y};
                o = __builtin_amdgcn_mfma_f32_32x32x16_bf16(pf[s], __builtin_bit_cast(bf16x8, w), o, 0, 0, 0); }
#pragma unroll
            for (int i = 0; i < 16; ++i) { const int qr = (i & 3) + 8 * (i >> 2) + 4 * hh; *(LAS bf16*)(ost + (qr * 32 + r) * 2) = (bf16)f2bf(o[i]); }
            const v4u o0 = *(const LAS v4u*)(ost + (lane >> 1) * 64 + (lane & 1) * 32), o1 = *(const LAS v4u*)(ost + (lane >> 1) * 64 + (lane & 1) * 32 + 16);
            bf16* op = Og + (size_t)(lane >> 1) * D + db * 32 + (lane & 1) * 16;
            *(v4u*)op = o0; *(v4u*)(op + 8) = o1;
        }
    }
#undef ATT_DMA
    __syncthreads();
}
#ifndef PHMASK
#define PHMASK 0xFFFFFFFFu
#endif
#define PHON(i) ((PHMASK >> (i)) & 1u)
__global__ void __launch_bounds__(NWAVES * 64, 2) skel_fwd(Args args) {
    extern __shared__ __attribute__((aligned(16))) unsigned char lds[];
    Frame F;
    F.lds = (LAS unsigned char*)lds; F.MISC = (volatile LAS unsigned*)(F.lds + MISC_OFF);
    F.tid = threadIdx.x; F.lane = F.tid & 63; F.wave = __builtin_amdgcn_readfirstlane(F.tid >> 6);
    F.G = gridDim.x; { const int bx = blockIdx.x; F.vcu = (F.G % 8 == 0) ? (bx % 8) * (F.G / 8) + bx / 8 : bx; }
    F.X = args.out; F.ws = args.ws; F.ctl = (gu32*)(args.ws + WS_CTL);
    for (int u = F.tid; u < 128; u += NWAVES * 64) ((LAS unsigned*)(F.lds + MISC_OFF))[u] = 0u;
    __syncthreads();
    XcdBarrier bar; bar.bar = (unsigned*)(F.ctl + CW_BAR); bar.x = 0; bar.st = nullptr;
    const bool multi = (args.ph_hi - args.ph_lo) > 1;
    if (multi) bar = xcd_barrier_post((unsigned*)(F.ctl + CW_BAR), F.MISC + 8);
    unsigned char* ws = args.ws;
    LAS unsigned char* ring = F.lds;
    typedef pg8::bf16_t bt; typedef const pg8::bf16_t cbt;
#ifndef PROBE_K
#define PROBE_K -100
#define PROBE_N 0
#endif
    for (int ph = args.ph_lo, rep = 0; ph < args.ph_hi; ) {
        const int l = ph == 0 ? 0 : (ph - 1) / 15, k = ph == 0 ? -1 : (ph - 1) % 15;
        int c = (int)blockIdx.x; asm volatile("" : "+s"(c));
        F.vcu = (F.G % 8 == 0) ? (c % 8) * (F.G / 8) + c / 8 : c;
        { int t_ = threadIdx.x; asm volatile("" : "+v"(t_)); F.tid = t_; F.lane = t_ & 63; F.wave = __builtin_amdgcn_readfirstlane(t_ >> 6); }
        KArgs A = (KArgs)__builtin_amdgcn_kernarg_segment_ptr(); asm volatile("" : "+s"(A));
        ws = A->ws; F.ws = ws; F.X = A->out; F.ctl = (gu32*)(ws + WS_CTL);
        switch (k) {
        case -1: if (PHON(0)) p0_prologue(A, F); break;
        case 1: if (PHON(2)) { if (F.vcu < BATCH * RET_H) retention_unit(A, F, l, F.vcu); else rwkv_prep(A, F, l, F.vcu - BATCH * RET_H, F.G - BATCH * RET_H); } break;
        case 2: if (PHON(3)) rwkv_scan(F); break;
        case 6: if (PHON(7)) { ln_phase<false>(A, F, l, IN(22) + (size_t)l * D, IN(23) + (size_t)l * D); convert_wm(A, F, l); } break;
        case 8: if (PHON(9)) attn_phase(F); break;
        case 10: if (PHON(10)) ln_phase<true>(A, F, l, IN(27) + (size_t)l * D, IN(28) + (size_t)l * D); break;
        case 11: if (PHON(11)) moe_gather(F, l); break;
        case 12: case 13: if (PHON(12)) moe_prefix(F, l); break;
        case 14: if (PHON(14)) { moe_combine_ln(F, l, IN(32) + (size_t)l * D, IN(33) + (size_t)l * D); if (l + 1 < DEPTH) convert_wa(A, F, l + 1); } break;
        default: break;
        }
        const int njobs = (k == 0) ? 3 : (k == 4) ? 2 : (k == 3 || k == 5 || k == 7 || k == 9 || k == 12 || k == 13) ? 1 : 0;
        if (PHON(1))
        for (int j = 0; j < njobs; ++j) {
            pg8::Gemm g{nullptr, nullptr, 0, 0, D}; int M = T, N = D, moe = 0;
            pg8::EpiU E{pg8::EM_BF16, nullptr, D, 0xffff, nullptr, 0, 0xffff, 0, 1.f, nullptr, nullptr};
            if (k == 0) {
                if (j == 0) { g.A = (cbt*)(ws + WS_XN); g.Bt = (cbt*)(ws + WS_WIN); N = N1; E.O0 = (bt*)(ws + WS_PRET); E.ld0 = 2048; E.npn0 = 8; E.O1 = (bt*)(ws + WS_PRW); E.ld1 = RW_COLS; }
                else if (j == 1) { g.A = (cbt*)(ws + WS_MEMB); g.Bt = (cbt*)(ws + WS_WKV); M = MEMT; E.O0 = (bt*)(ws + WS_MK); }
                else { g.A = (cbt*)(ws + WS_WKV) + (size_t)D * D; g.Bt = (cbt*)(ws + WS_MEMB); M = D; N = MEMT; E.O0 = (bt*)(ws + WS_VT); E.ld0 = MEMT; }
            } else if (k == 3) { g.A = (cbt*)(ws + WS_XN); g.Bt = (cbt*)(ws + WS_WIN) + (size_t)N1 * D; N = NGATE; E.O0 = (bt*)(ws + WS_PGATE); E.ld0 = NGATE; E.act = 1; }
            else if (k == 4) { g.K = RET_W; E.G = (cbt*)(ws + WS_PGATE); E.F = (float*)(ws + WS_M1); E.O0 = (bt*)(ws + WS_MRG);
                if (j == 0) { g.A = (cbt*)(ws + WS_YR); g.Bt = (cbt*)(ws + WS_WRU); E.mode = pg8::EM_MERGE0; } else { g.A = (cbt*)(ws + WS_YK); g.Bt = (cbt*)(ws + WS_WKU); E.mode = pg8::EM_MERGE1; } }
            else if (k == 5) { g.A = (cbt*)(ws + WS_MRG); g.Bt = (cbt*)(ws + WS_WOUT); E.mode = pg8::EM_F32; E.F = (float*)(ws + WS_H1); }
            else if (k == 7) { g.A = (cbt*)(ws + WS_XN); g.Bt = (cbt*)(ws + WS_WQ); E.O0 = (bt*)(ws + WS_Q); E.scale = 0.0625f * 1.44269504f; }
            else if (k == 9) { g.A = (cbt*)(ws + WS_O); g.Bt = (cbt*)(ws + WS_WO); E.mode = pg8::EM_F32; E.F = (float*)(ws + WS_H1); }
            else if (k == 12) { g.A = (cbt*)(ws + WS_XG); g.Bt = (cbt*)(ws + WS_WMA); moe = 1; E.mode = pg8::EM_MOEA; E.O0 = (bt*)(ws + WS_HM); }
            else { g.A = (cbt*)(ws + WS_HM); g.Bt = (cbt*)(ws + WS_WMB); g.K = DE; moe = 1; E.O0 = (bt*)(ws + WS_YM); E.pn_mask = 3; }
            pg8::OrderU S; S.st.init(M, N, F.G, c); S.moe = moe; S.tp = (const LAS int*)(F.lds + MISC_OFF + 128);
            pg8::gemm_phase<pg8::EpiU, pg8::OrderU, true, true>(ring, g, S, E);
        }
        if (k == 3 && PHON(4)) rwkv_finish(A, F, l);
        if (ph + 1 < args.ph_hi) xcd_barrier(bar);
        if (k == PROBE_K && rep < PROBE_N) ++rep; else { rep = 0; ++ph; }
    }
}

extern "C" void kernel_launch(void* const* d_in, const int* in_sizes, int n_in, void* d_out, int out_size, void* d_ws, size_t ws_size, hipStream_t stream) {
    static int grid = 0;
    if (grid == 0) {
        if (n_in != 34 || in_sizes[0] != T * D || out_size != T * D || ws_size < WS_END) { fprintf(stderr, "kernel_launch: unexpected problem shape (n_in %d, in0 %d, out %d, ws %zu, need %zu)\n", n_in, n_in > 0 ? in_sizes[0] : -1, out_size, ws_size, (size_t)WS_END); grid = -1; return; }
        int dev = 0, cus = 0;
        if (hipGetDevice(&dev) != hipSuccess || hipDeviceGetAttribute(&cus, hipDeviceAttributeMultiprocessorCount, dev) != hipSuccess) { grid = -1; return; }
        if (hipFuncSetAttribute((const void*)skel_fwd, hipFuncAttributeMaxDynamicSharedMemorySize, LDS_BYTES) != hipSuccess) { fprintf(stderr, "kernel_launch: hipFuncSetAttribute failed\n"); grid = -1; return; }
        int per_cu = 0;
        if (hipOccupancyMaxActiveBlocksPerMultiprocessor(&per_cu, (const void*)skel_fwd, NWAVES * 64, LDS_BYTES) != hipSuccess || per_cu < 1) fprintf(stderr, "kernel_launch: occupancy query reports %d\n", per_cu);
        (void)hipGetLastError();
        grid = cus;
        if (grid != 256) fprintf(stderr, "kernel_launch: %d CUs (built for 256)\n", grid);
    }
    if (grid < 0) return;
    (void)hipMemsetAsync((char*)d_ws + WS_CTL, 0, CTL_ZERO_BYTES, stream);
    Args a{};
    for (int i = 0; i < 34; ++i) a.in[i] = (const float*)d_in[i];
    a.out = (float*)d_out; a.ws = (unsigned char*)d_ws;
#if MK_ONE_LAUNCH
    a.ph_lo = 0; a.ph_hi = N_PHASES;
    hipLaunchKernelGGL(skel_fwd, dim3(grid), dim3(NWAVES * 64), LDS_BYTES, stream, a);
#else
    for (int ph = 0; ph < N_PHASES; ++ph) { a.ph_lo = ph; a.ph_hi = ph + 1; hipLaunchKernelGGL(skel_fwd, dim3(grid), dim3(NWAVES * 64), LDS_BYTES, stream, a); }
#endif
}
```
